# Optimizing an MI355X kernel written in HIP

```python
import math
import jax, jax.numpy as jnp
from jax import lax
import numpy as np

D_MODEL = 2048
BATCH = 4
SEQ = 4096
DEPTH = 2

N_ATTN_LAYERS = (DEPTH + 1) // 2
N_REC_LAYERS = DEPTH // 2
Q_BLOCK = 128
NEG_INF = -1e30
NORM_EPS = 1e-6

A_HEADS = 8
A_QK_DIM = 64
A_V_DIM = 2 * A_QK_DIM
A_SUBLN_EPS = 1e-5

B_HEADS = 8
B_Q_LORA = 768
B_KV_LORA = 512
B_NOPE_DIM = 128
B_ROPE_DIM = 64
B_V_DIM = 128
B_QK_DIM = B_NOPE_DIM + B_ROPE_DIM
ROPE_THETA = 10000.0

A_Q_COLS = A_HEADS * 2 * A_QK_DIM
A_K_COLS = A_HEADS * 2 * A_QK_DIM
A_V_COLS = A_HEADS * A_V_DIM
ATTN_IN_COLS = A_Q_COLS + A_K_COLS + A_V_COLS + B_Q_LORA + B_KV_LORA + B_ROPE_DIM
MIX_WIDTH = A_HEADS * A_V_DIM + B_HEADS * B_V_DIM

LRU_WIDTH = D_MODEL
LRU_BLOCKS = 8
LRU_BLOCK_W = LRU_WIDTH // LRU_BLOCKS
CONV_WIDTH = 4
LRU_C = 8.0

D_FF = 4 * D_MODEL

kernel_name = "hybrid_diffattn_mla_rglru_block"


def rms_norm(x, g, eps=NORM_EPS):
    xf = x.astype(jnp.float32)
    y = xf * lax.rsqrt(jnp.mean(xf * xf, axis=-1, keepdims=True) + eps)
    return (y * g.astype(jnp.float32)).astype(x.dtype)


def rope_tables(positions):
    inv_freq = 1.0 / (ROPE_THETA ** (jnp.arange(0, B_ROPE_DIM, 2, dtype=jnp.float32) / B_ROPE_DIM))
    ang = positions.astype(jnp.float32)[..., None] * inv_freq
    return jnp.cos(ang)[:, :, None, :], jnp.sin(ang)[:, :, None, :]


def apply_rope(x, cos, sin):
    xf = x.astype(jnp.float32)
    x1, x2 = jnp.split(xf, 2, axis=-1)
    out = jnp.concatenate([x1 * cos - x2 * sin, x2 * cos + x1 * sin], axis=-1)
    return out.astype(x.dtype)


def causal_block_attention(q, k, v, scale):
    B, H, M, S, dk = q.shape
    dv = v.shape[-1]
    nb = S // Q_BLOCK
    qb = jnp.moveaxis(q.reshape(B, H, M, nb, Q_BLOCK, dk), 3, 0)
    kf = k.astype(jnp.float32)
    vf = v.astype(jnp.float32)
    key_pos = jnp.arange(S)

    def one_block(args):
        q_blk, start = args
        s = jnp.einsum('bhmqd,bhmkd->bhmqk', q_blk.astype(jnp.float32), kf) * scale
        q_pos = start + jnp.arange(Q_BLOCK)
        mask = key_pos[None, :] <= q_pos[:, None]
        p = jax.nn.softmax(jnp.where(mask, s, NEG_INF), axis=-1)
        return jnp.einsum('bhmqk,bhkv->bhmqv', p, vf)

    starts = jnp.arange(nb) * Q_BLOCK
    out = lax.map(one_block, (qb, starts))
    out = jnp.moveaxis(out, 0, 3).reshape(B, H, M, S, dv)
    return out.astype(q.dtype)


def attention_mixer(h, cos, sin, layer_idx, w_in, lq1, lk1, lq2, lk2, subln,
                    q_norm, kv_norm, w_uq, w_ukv, w_out):
    B, S, _ = h.shape
    proj = h @ w_in
    o0 = A_Q_COLS
    o1 = o0 + A_K_COLS
    o2 = o1 + A_V_COLS
    o3 = o2 + B_Q_LORA
    o4 = o3 + B_KV_LORA
    qa, ka, va = proj[..., :o0], proj[..., o0:o1], proj[..., o1:o2]
    cq, ckv, kr = proj[..., o2:o3], proj[..., o3:o4], proj[..., o4:]

    qa = jnp.transpose(qa.reshape(B, S, A_HEADS, 2, A_QK_DIM), (0, 2, 3, 1, 4))
    ka = jnp.transpose(ka.reshape(B, S, A_HEADS, 2, A_QK_DIM), (0, 2, 3, 1, 4))
    va = jnp.transpose(va.reshape(B, S, A_HEADS, A_V_DIM), (0, 2, 1, 3))
    oa = causal_block_attention(qa, ka, va, A_QK_DIM ** -0.5)
    lambda_init = 0.8 - 0.6 * math.exp(-0.3 * layer_idx)
    lam = (jnp.exp(jnp.sum(lq1.astype(jnp.float32) * lk1.astype(jnp.float32)))
           - jnp.exp(jnp.sum(lq2.astype(jnp.float32) * lk2.astype(jnp.float32)))
           + lambda_init)
    oa = oa[:, :, 0] - lam.astype(oa.dtype) * oa[:, :, 1]
    oa = rms_norm(oa, subln, A_SUBLN_EPS) * (1.0 - lambda_init)
    oa = jnp.transpose(oa, (0, 2, 1, 3)).reshape(B, S, A_HEADS * A_V_DIM)

    q = (rms_norm(cq, q_norm) @ w_uq).reshape(B, S, B_HEADS, B_QK_DIM)
    q = jnp.concatenate([q[..., :B_NOPE_DIM], apply_rope(q[..., B_NOPE_DIM:], cos, sin)], axis=-1)
    kv = (rms_norm(ckv, kv_norm) @ w_ukv).reshape(B, S, B_HEADS, B_NOPE_DIM + B_V_DIM)
    k_nope, vb = kv[..., :B_NOPE_DIM], kv[..., B_NOPE_DIM:]
    k_rope = apply_rope(kr[:, :, None, :], cos, sin)
    k = jnp.concatenate([k_nope, jnp.broadcast_to(k_rope, (B, S, B_HEADS, B_ROPE_DIM))], axis=-1)
    q = jnp.transpose(q, (0, 2, 1, 3))[:, :, None]
    k = jnp.transpose(k, (0, 2, 1, 3))[:, :, None]
    vb = jnp.transpose(vb, (0, 2, 1, 3))
    ob = causal_block_attention(q, k, vb, B_QK_DIM ** -0.5)[:, :, 0]
    ob = jnp.transpose(ob, (0, 2, 1, 3)).reshape(B, S, B_HEADS * B_V_DIM)

    o = jnp.concatenate([oa.astype(h.dtype), ob.astype(h.dtype)], axis=-1)
    return o @ w_out


def recurrent_mixer(h, w_in, conv_w, conv_b, w_a, b_a, w_x, b_x, lam, w_out):
    B, S, _ = h.shape
    proj = h @ w_in
    y = jax.nn.gelu(proj[..., :LRU_WIDTH], approximate=True)
    xr = proj[..., LRU_WIDTH:]
    xc = lax.conv_general_dilated(
        xr, conv_w[:, None, :], window_strides=(1,), padding=[(CONV_WIDTH - 1, 0)],
        dimension_numbers=('NWC', 'WIO', 'NWC'), feature_group_count=LRU_WIDTH) + conv_b
    xb = xc.reshape(B, S, LRU_BLOCKS, LRU_BLOCK_W)
    r = jax.nn.sigmoid((jnp.einsum('bsni,nio->bsno', xb, w_a) + b_a).astype(jnp.float32))
    i = jax.nn.sigmoid((jnp.einsum('bsni,nio->bsno', xb, w_x) + b_x).astype(jnp.float32))
    r = r.reshape(B, S, LRU_WIDTH)
    i = i.reshape(B, S, LRU_WIDTH)
    log_a = -LRU_C * r * jax.nn.softplus(-lam.astype(jnp.float32))
    a = jnp.exp(log_a)
    b = jnp.sqrt(-jnp.expm1(2.0 * log_a)) * (i * xc.astype(jnp.float32))

    def combine(c1, c2):
        a1, b1 = c1
        a2, b2 = c2
        return a1 * a2, a2 * b1 + b2

    _, hs = lax.associative_scan(combine, (a, b), axis=1)
    return (y * hs.astype(h.dtype)) @ w_out


def squared_relu_mlp(h, w1, w2):
    u = jax.nn.relu(h @ w1)
    return (u * u) @ w2


def setup_inputs(seed: int = 0) -> dict:
    key = jax.random.key(seed)
    ks = iter(jax.random.split(key, 40))
    f32 = jnp.float32

    def dense(shape, fan_in):
        return jax.random.normal(next(ks), shape, f32) * (fan_in ** -0.5)

    def gain(shape):
        return 1.0 + 0.02 * jax.random.normal(next(ks), shape, f32)

    def small(shape, scale=0.01):
        return scale * jax.random.normal(next(ks), shape, f32)

    nA, nR = N_ATTN_LAYERS, N_REC_LAYERS
    x = jax.random.normal(next(ks), (BATCH, SEQ, D_MODEL), f32)
    offsets = jax.random.randint(next(ks), (BATCH, 1), 0, 1024, dtype=jnp.int32)
    positions = offsets + jnp.arange(SEQ, dtype=jnp.int32)[None, :]

    a_c = jax.random.uniform(next(ks), (nR, LRU_WIDTH), f32, 0.81, 0.998)
    s = a_c ** (1.0 / LRU_C)
    rec_lambda = jnp.log(s) - jnp.log1p(-s)

    return {
        "x": x,
        "positions": positions,
        "norm_mix": gain((DEPTH, D_MODEL)),
        "norm_mlp": gain((DEPTH, D_MODEL)),
        "norm_final": gain((D_MODEL,)),
        "attn_w_in": dense((nA, D_MODEL, ATTN_IN_COLS), D_MODEL),
        "attn_lambda_q1": small((nA, A_QK_DIM), 0.1),
        "attn_lambda_k1": small((nA, A_QK_DIM), 0.1),
        "attn_lambda_q2": small((nA, A_QK_DIM), 0.1),
        "attn_lambda_k2": small((nA, A_QK_DIM), 0.1),
        "attn_subln": gain((nA, A_V_DIM)),
        "attn_q_norm": gain((nA, B_Q_LORA)),
        "attn_kv_norm": gain((nA, B_KV_LORA)),
        "attn_w_uq": dense((nA, B_Q_LORA, B_HEADS * B_QK_DIM), B_Q_LORA),
        "attn_w_ukv": dense((nA, B_KV_LORA, B_HEADS * (B_NOPE_DIM + B_V_DIM)), B_KV_LORA),
        "attn_w_out": dense((nA, MIX_WIDTH, D_MODEL), MIX_WIDTH),
        "rec_w_in": dense((nR, D_MODEL, 2 * LRU_WIDTH), D_MODEL),
        "rec_conv_w": dense((nR, CONV_WIDTH, LRU_WIDTH), CONV_WIDTH),
        "rec_conv_b": small((nR, LRU_WIDTH)),
        "rec_w_a": dense((nR, LRU_BLOCKS, LRU_BLOCK_W, LRU_BLOCK_W), LRU_BLOCK_W),
        "rec_b_a": small((nR, LRU_BLOCKS, LRU_BLOCK_W)),
        "rec_w_x": dense((nR, LRU_BLOCKS, LRU_BLOCK_W, LRU_BLOCK_W), LRU_BLOCK_W),
        "rec_b_x": small((nR, LRU_BLOCKS, LRU_BLOCK_W)),
        "rec_lambda": rec_lambda,
        "rec_w_out": dense((nR, LRU_WIDTH, D_MODEL), LRU_WIDTH),
        "mlp_w1": dense((DEPTH, D_MODEL, D_FF), D_MODEL),
        "mlp_w2": dense((DEPTH, D_FF, D_MODEL), D_FF),
    }


def reference(x, positions, norm_mix, norm_mlp, norm_final,
              attn_w_in, attn_lambda_q1, attn_lambda_k1, attn_lambda_q2, attn_lambda_k2,
              attn_subln, attn_q_norm, attn_kv_norm, attn_w_uq, attn_w_ukv, attn_w_out,
              rec_w_in, rec_conv_w, rec_conv_b, rec_w_a, rec_b_a, rec_w_x, rec_b_x,
              rec_lambda, rec_w_out, mlp_w1, mlp_w2):
    cos, sin = rope_tables(positions)
    h = x
    for layer in range(DEPTH):
        j = layer // 2
        hn = rms_norm(h, norm_mix[layer])
        if layer % 2 == 0:
            mix = attention_mixer(hn, cos, sin, layer, attn_w_in[j],
                                  attn_lambda_q1[j], attn_lambda_k1[j],
                                  attn_lambda_q2[j], attn_lambda_k2[j], attn_subln[j],
                                  attn_q_norm[j], attn_kv_norm[j], attn_w_uq[j],
                                  attn_w_ukv[j], attn_w_out[j])
        else:
            mix = recurrent_mixer(hn, rec_w_in[j], rec_conv_w[j], rec_conv_b[j],
                                  rec_w_a[j], rec_b_a[j], rec_w_x[j], rec_b_x[j],
                                  rec_lambda[j], rec_w_out[j])
        h = h + mix.astype(h.dtype)
        h = h + squared_relu_mlp(rms_norm(h, norm_mlp[layer]), mlp_w1[layer], mlp_w2[layer]).astype(h.dtype)
    return rms_norm(h, norm_final)
```

```cpp
#include <hip/hip_runtime.h>
#include <hip/hip_cooperative_groups.h>
#include <cstdio>
#include <cmath>
#include <cstring>
namespace cg = cooperative_groups;

#ifndef N_LAUNCH_MODE
#define N_LAUNCH_MODE 1
#endif

#ifdef ONLY
#ifdef ONLY2
#define EN(n) ((n)==ONLY || (n)==ONLY2 || (n)==ONLY3)
#else
#define EN(n) ((n)==ONLY)
#endif
#else
#define EN(n) true
#endif
#define LAS __attribute__((address_space(3)))
#define DI __device__ __forceinline__
typedef unsigned short bf16_t;
typedef short bf16x8 __attribute__((ext_vector_type(8)));
typedef short s16x4 __attribute__((ext_vector_type(4)));
typedef float f32x2 __attribute__((ext_vector_type(2)));
typedef float f32x4 __attribute__((ext_vector_type(4)));
typedef float f32x16 __attribute__((ext_vector_type(16)));
typedef unsigned u32x2 __attribute__((ext_vector_type(2)));
typedef unsigned u32x4 __attribute__((ext_vector_type(4)));
typedef unsigned long long u64_t;


constexpr int T_TOK = 16384, SEQ = 4096, DM = 2048, NB = 4;
constexpr int LDS_BYTES = 131072;

struct GD { const bf16_t* A; const bf16_t* Bt; void* p0; void* p1; const void* q0; const void* q1; const void* q2; const void* q3; int M, N, K, lda, ldb, gate, kind, ld0, ld1, split, mode, pad; };
struct Params {
  const float* x; const int* pos; const float* norm_mix; const float* norm_mlp; const float* norm_final;
  const float* w_in; const float* lq1; const float* lk1; const float* lq2; const float* lk2; const float* subln;
  const float* q_norm; const float* kv_norm; const float* w_uq; const float* w_ukv; const float* w_out;
  const float* rw_in; const float* conv_w; const float* conv_b; const float* w_a; const float* b_a; const float* w_x; const float* b_x;
  const float* rlam; const float* rw_out; const float* w1; const float* w2;
  float* out;
  bf16_t *Wt_in, *Wt_uq, *Wt_ukv, *Wt_out, *Wt_rin, *Wt_gate, *Wt_rout, *Wt_w1, *Wt_w2;
  bf16_t* act; bf16_t* X; float* cs; float* sp8; unsigned* bar; u64_t* ssq;
  float inv_freq[32];
  int step_lo, step_hi;
  GD gd[11];
  int step_gd[24];
};
typedef const __attribute__((address_space(4))) Params* KParams;

DI unsigned cvt_pk_bf16(float lo, float hi) { unsigned r; asm volatile("v_cvt_pk_bf16_f32 %0, %1, %2" : "=v"(r) : "v"(lo), "v"(hi)); return r; }
DI float bf_lo(unsigned w) { return __uint_as_float(w << 16); }
DI float bf_hi(unsigned w) { return __uint_as_float(w & 0xffff0000u); }
DI float bf2f(bf16_t b) { return __uint_as_float(((unsigned)b) << 16); }
DI float wave_sum(float v) {
#pragma unroll
  for (int o = 32; o >= 1; o >>= 1) v += __shfl_xor(v, o);
  return v;
}

DI int tid_fresh() { int t = threadIdx.x; asm volatile("" : "+v"(t)); return t; }
namespace pg8 {
constexpr int BM = 256, BK = 64, HALF = 128, HTB = HALF * BK * 2, NXCD = 8, WGM = 8;
DI int lds_byte(int r, int c) { const int st = (r >> 4) * 2 + (c >> 5), rr = r & 15, cc = c & 31, ob = rr * 64 + cc * 2; return st * 1024 + (ob ^ (((ob >> 9) & 1) << 5)); }
DI void stage_rc(int b, int& R, int& C) { const int st = b / 1024, sb = b % 1024, swz = sb ^ (((sb >> 9) & 1) << 5); R = (st >> 1) * 16 + swz / 64; C = (st & 1) * 32 + (swz % 64) / 2; }
DI int perm32(int rho) { const int n = rho >> 4, i = rho & 15; return 8 * (i >> 2) + 4 * n + (i & 3); }

struct Unit { int pm, pn; };
struct Gemm { const bf16_t* A; const bf16_t* Bt; int M, N, K, lda, ldb, gate; };

struct StaticOrder {
  int nM, nN, nwg, G, c;
  DI void init(int M, int N, int G_, int c_) { nM = M / BM; nN = N / BM; nwg = nM * nN; G = G_; c = c_; }
  DI bool next(int i, Unit& u) const {
    const long L = (long)i * G + c; if (L >= nwg) return false;
    int wgid = (int)L; { const int q = nwg / NXCD, r = nwg % NXCD, xcd = wgid % NXCD, off = wgid / NXCD; wgid = (xcd < r ? xcd * (q + 1) : r * (q + 1) + (xcd - r) * q) + off; }
    const int nig = WGM * nN, gid = wgid / nig, fm = gid * WGM, gsz = (nM - fm) < WGM ? (nM - fm) : WGM;
    u.pm = fm + ((wgid % nig) % gsz); u.pn = (wgid % nig) / gsz; return true;
  }
};

template <class Epi>
DI void gemm_phase(LAS unsigned char* lds, const Gemm g, const StaticOrder& S, const Epi& E) {
  const int tid = tid_fresh(), wid = __builtin_amdgcn_readfirstlane(tid >> 6), lane = tid & 63, wr = wid >> 2, wc = wid & 3, fr = lane & 15, fq = lane >> 4;
  const int K = g.K, nt = K / BK;
  unsigned voffA[2], voffB[2];
#pragma unroll
  for (int i = 0; i < 2; ++i) { int R, C; stage_rc(tid * 16 + i * 8192, R, C); const int Rb = Epi::PERM ? ((R & ~31) + perm32(R & 31)) : R;
    voffA[i] = (unsigned)(R * g.lda + C) * 2u; voffB[i] = (unsigned)(Rb * g.ldb + C) * 2u; }
  const size_t kstep = (size_t)(BK * 2);
  const size_t hstepA = (size_t)HALF * g.lda * 2, hstepB = (size_t)HALF * g.ldb * 2;
  const unsigned ldsw = (unsigned)wid * 1024u;
  const int aoff = lds_byte(wr * 64 + fr, fq * 8), boff = lds_byte(wc * 32 + fr, fq * 8);
#define PG8_UA(u) ((const char*)g.A + ((size_t)(u).pm * 256 * g.lda + (g.gate ? (size_t)((u).pn >> 1) * 256 : 0)) * 2)
#define PG8_UB(u) ((const char*)g.Bt + ((size_t)(u).pn * 256 * g.ldb) * 2)
#define PG8_SA(b, h) (((b) * 2 + (h)) * HTB)
#define PG8_SB(b, h) ((4 + (b) * 2 + (h)) * HTB)
#define PG8_STAGE(bufoff, gbase, voff) do { _Pragma("unroll") for (int _i = 0; _i < 2; ++_i) \
    __builtin_amdgcn_global_load_lds((const unsigned*)((const char*)(gbase) + (voff)[_i]), (LAS unsigned*)(lds + (bufoff) + ldsw + _i * 8192), 16, 0, 0); } while (0)
#define PG8_LDA(dst, b, h) do { _Pragma("unroll") for (int m = 0; m < 4; ++m) _Pragma("unroll") for (int k = 0; k < 2; ++k) dst[m][k] = *(const LAS bf16x8*)(lds + PG8_SA(b, h) + aoff + m * 2048 + k * 1024); } while (0)
#define PG8_LDB(dst, b, h) do { _Pragma("unroll") for (int n = 0; n < 2; ++n) _Pragma("unroll") for (int k = 0; k < 2; ++k) dst[n][k] = *(const LAS bf16x8*)(lds + PG8_SB(b, h) + boff + n * 2048 + k * 1024); } while (0)
#define PG8_MMA(ai, bj, At, Bt) do { __builtin_amdgcn_s_setprio(1); _Pragma("unroll") for (int m = 0; m < 4; ++m) _Pragma("unroll") for (int n = 0; n < 2; ++n) _Pragma("unroll") for (int k = 0; k < 2; ++k) \
    acc[ai][bj][m][n] = __builtin_amdgcn_mfma_f32_16x16x32_bf16(Bt[n][k], At[m][k], acc[ai][bj][m][n], 0, 0, 0); __builtin_amdgcn_s_setprio(0); } while (0)
#define PG8_WAIT_V(n) asm volatile("s_waitcnt vmcnt(" #n ")" ::: "memory")
#define PG8_WAIT_L(n) asm volatile("s_waitcnt lgkmcnt(" #n ")" ::: "memory")
#define PG8_BAR __builtin_amdgcn_s_barrier()
#define PG8_SCHED __builtin_amdgcn_sched_barrier(0)
  Unit cur, nxt; int ui = 0;
  if (!S.next(0, cur)) return;
  f32x4 acc[2][2][4][2];
#pragma unroll
  for (int a = 0; a < 2; ++a)
#pragma unroll
    for (int b = 0; b < 2; ++b)
#pragma unroll
      for (int m = 0; m < 4; ++m)
#pragma unroll
        for (int n = 0; n < 2; ++n) acc[a][b][m][n] = (f32x4){0.f, 0.f, 0.f, 0.f};
  bf16x8 At[4][2], B0[2][2], B1[2][2];
  const char* cA = PG8_UA(cur); const char* cB = PG8_UB(cur);
  PG8_STAGE(PG8_SB(0, 0), cB, voffB); PG8_STAGE(PG8_SB(0, 1), cB + hstepB, voffB); PG8_STAGE(PG8_SA(0, 0), cA, voffA); PG8_STAGE(PG8_SA(0, 1), cA + hstepA, voffA);
  if (wr == 1) PG8_BAR;
  PG8_WAIT_V(2); PG8_BAR;
  PG8_STAGE(PG8_SB(1, 0), cB + kstep, voffB); PG8_STAGE(PG8_SA(1, 0), cA + kstep, voffA); PG8_STAGE(PG8_SB(1, 1), cB + hstepB + kstep, voffB);
  PG8_WAIT_V(6); PG8_BAR;
  for (;;) {
    const bool has_next = S.next(ui + 1, nxt);
    const char* nA = has_next ? PG8_UA(nxt) : cA; const char* nB = has_next ? PG8_UB(nxt) : cB;
    for (int t = 0; t < nt; t += 2) {
      const bool last = (t == nt - 2);
      const char* a1 = cA + (size_t)(t + 1) * kstep;
      const char* a2 = last ? nA : cA + (size_t)(t + 2) * kstep; const char* b2 = last ? nB : cB + (size_t)(t + 2) * kstep;
      const char* a3 = a2 + kstep; const char* b3 = b2 + kstep;
      PG8_LDB(B0, 0, 0); PG8_LDB(B1, 0, 1); PG8_SCHED; PG8_LDA(At, 0, 0); PG8_STAGE(PG8_SA(1, 1), a1 + hstepA, voffA);
      PG8_WAIT_V(8); PG8_WAIT_L(0); PG8_BAR; PG8_MMA(0, 0, At, B0); PG8_MMA(0, 1, At, B1); PG8_BAR; PG8_SCHED;
      PG8_LDA(At, 0, 1); PG8_STAGE(PG8_SB(0, 0), b2, voffB); PG8_STAGE(PG8_SB(0, 1), b2 + hstepB, voffB); PG8_STAGE(PG8_SA(0, 0), a2, voffA);
      PG8_WAIT_V(8); PG8_WAIT_L(0); PG8_BAR; PG8_MMA(1, 0, At, B0); PG8_MMA(1, 1, At, B1); PG8_BAR; PG8_SCHED;
      PG8_LDB(B0, 1, 0); PG8_LDB(B1, 1, 1); PG8_SCHED; PG8_LDA(At, 1, 0); PG8_STAGE(PG8_SA(0, 1), a2 + hstepA, voffA);
      PG8_WAIT_V(8); PG8_WAIT_L(0); PG8_BAR; PG8_MMA(0, 0, At, B0); PG8_MMA(0, 1, At, B1); PG8_BAR; PG8_SCHED;
      PG8_LDA(At, 1, 1); PG8_STAGE(PG8_SB(1, 0), b3, voffB); PG8_STAGE(PG8_SB(1, 1), b3 + hstepB, voffB); PG8_STAGE(PG8_SA(1, 0), a3, voffA);
      PG8_WAIT_V(8); PG8_WAIT_L(0); PG8_BAR; PG8_MMA(1, 0, At, B0); PG8_MMA(1, 1, At, B1); PG8_BAR; PG8_SCHED;
    }
    if (wr == 0) PG8_BAR;
    E(acc, cur, wr, wc, fr, fq);
    if (!has_next) break;
#pragma unroll
    for (int a = 0; a < 2; ++a)
#pragma unroll
      for (int b = 0; b < 2; ++b)
#pragma unroll
        for (int m = 0; m < 4; ++m)
#pragma unroll
          for (int n = 0; n < 2; ++n) acc[a][b][m][n] = (f32x4){0.f, 0.f, 0.f, 0.f};
    cur = nxt; cA = nA; cB = nB; ++ui;
    if (wr == 1) PG8_BAR;
  }
  PG8_WAIT_V(0);
  PG8_BAR;
#undef PG8_UA
#undef PG8_UB
#undef PG8_SA
#undef PG8_SB
#undef PG8_STAGE
#undef PG8_LDA
#undef PG8_LDB
#undef PG8_MMA
#undef PG8_WAIT_V
#undef PG8_WAIT_L
#undef PG8_BAR
#undef PG8_SCHED
}
}
using pg8::Unit; using pg8::Gemm; using pg8::StaticOrder;

struct EpiBf {
  static constexpr bool PERM = true;
  bf16_t* o0; int ld0; bf16_t* o1; int ld1; int split; int mode; const float* cs;
  const u64_t* ssq; float inv_n;
  u64_t* sqa; u64_t* sqb;
  DI void operator()(const f32x4 (&acc)[2][2][4][2], const Unit& u, int wr, int wc, int fr, int fq) const {
    const int row0 = u.pm * 256 + wr * 64 + fr;
    bf16_t* base; int ld, colt;
    if (u.pn < split) { base = o0; ld = ld0; colt = u.pn * 256; } else { base = o1; ld = ld1; colt = (u.pn - split) * 256; }
    const bool gelu = (mode == 2) && (u.pn < split);
    u64_t* sq = nullptr;
    if (mode == 4) { if (u.pn >= 12 && u.pn < 15) sq = sqa; else if (u.pn >= 15 && u.pn < 17) sq = sqb; }
    const bool krope = (mode == 4) && (u.pn == 17) && (wc < 2);
    float rsv[8];
#pragma unroll
    for (int i = 0; i < 8; ++i) rsv[i] = 1.f;
    if (ssq) {
#pragma unroll
      for (int i = 0; i < 8; ++i) rsv[i] = (float)ssq[row0 + (i >> 2) * 128 + (i & 3) * 16];
#pragma unroll
      for (int i = 0; i < 8; ++i) rsv[i] = rsqrtf(rsv[i] * inv_n + 1e-6f);
    }
#pragma unroll
    for (int ai = 0; ai < 2; ++ai)
#pragma unroll
      for (int m = 0; m < 4; ++m) {
        const int row = row0 + ai * 128 + m * 16;
        bf16_t* rowp = base + (size_t)row * ld + colt + wc * 32 + 8 * fq;
        const float rs = rsv[ai * 4 + m];
        if (sq) {
          float ss = 0.f;
#pragma unroll
          for (int bj = 0; bj < 2; ++bj)
#pragma unroll
            for (int n = 0; n < 2; ++n) { const f32x4 x = acc[ai][bj][m][n]; ss += x[0] * x[0] + x[1] * x[1] + x[2] * x[2] + x[3] * x[3]; }
          ss += __shfl_xor(ss, 16); ss += __shfl_xor(ss, 32);
          if (fq == 0) atomicAdd(sq + row, (u64_t)(ss * 1048576.f));
        }
#pragma unroll
        for (int bj = 0; bj < 2; ++bj) {
          f32x4 v0 = acc[ai][bj][m][0] * rs, v1 = acc[ai][bj][m][1] * rs;
          if (krope && bj == 0) {
            const float* c = cs + ((size_t)row * 32 + (wc * 32 + 8 * fq) / 2) * 2;
            const f32x4 cA = *(const f32x4*)c, cB = *(const f32x4*)(c + 4);
            f32x4 w0, w1;
            w0[0] = v0[0] * cA[0] - v0[1] * cA[1]; w0[1] = v0[1] * cA[0] + v0[0] * cA[1];
            w0[2] = v0[2] * cA[2] - v0[3] * cA[3]; w0[3] = v0[3] * cA[2] + v0[2] * cA[3];
            w1[0] = v1[0] * cB[0] - v1[1] * cB[1]; w1[1] = v1[1] * cB[0] + v1[0] * cB[1];
            w1[2] = v1[2] * cB[2] - v1[3] * cB[3]; w1[3] = v1[3] * cB[2] + v1[2] * cB[3];
            v0 = w0; v1 = w1;
          }
          if (mode == 1) {
#pragma unroll
            for (int j = 0; j < 4; ++j) { const float a = fmaxf(v0[j], 0.f), b = fmaxf(v1[j], 0.f); v0[j] = a * a; v1[j] = b * b; }
          }
          if (gelu) {
#pragma unroll
            for (int j = 0; j < 4; ++j) {
              { const float xx = v0[j]; const float z = 1.5957691216f * (xx + 0.044715f * xx * xx * xx); v0[j] = xx * __builtin_amdgcn_rcpf(1.f + __expf(-z)); }
              { const float xx = v1[j]; const float z = 1.5957691216f * (xx + 0.044715f * xx * xx * xx); v1[j] = xx * __builtin_amdgcn_rcpf(1.f + __expf(-z)); }
            }
          }
          if (mode == 3) {
            const int gc = u.pn * 256 + bj * 128 + wc * 32 + 8 * fq; const int ch = gc % 192;
            if (ch >= 128) {
              const float* c = cs + ((size_t)row * 32 + ((ch - 128) >> 1)) * 2;
              const f32x4 cA = *(const f32x4*)c, cB = *(const f32x4*)(c + 4);
              f32x4 w0, w1;
              w0[0] = v0[0] * cA[0] - v0[1] * cA[1]; w0[1] = v0[1] * cA[0] + v0[0] * cA[1];
              w0[2] = v0[2] * cA[2] - v0[3] * cA[3]; w0[3] = v0[3] * cA[2] + v0[2] * cA[3];
              w1[0] = v1[0] * cB[0] - v1[1] * cB[1]; w1[1] = v1[1] * cB[0] + v1[0] * cB[1];
              w1[2] = v1[2] * cB[2] - v1[3] * cB[3]; w1[3] = v1[3] * cB[2] + v1[2] * cB[3];
              v0 = w0; v1 = w1;
            }
          }
          u32x4 w; w.x = cvt_pk_bf16(v0[0], v0[1]); w.y = cvt_pk_bf16(v0[2], v0[3]); w.z = cvt_pk_bf16(v1[0], v1[1]); w.w = cvt_pk_bf16(v1[2], v1[3]);
          *(u32x4*)(rowp + bj * 128) = w;
        }
      }
  }
};
struct EpiRes {
  static constexpr bool PERM = false;
  const float* basef; const bf16_t* baseh; float* out; bf16_t* hb; u64_t* ssq;
  DI void operator()(const f32x4 (&acc)[2][2][4][2], const Unit& u, int wr, int wc, int fr, int fq) const {
    const int row0 = u.pm * 256 + wr * 64 + fr, col0 = u.pn * 256 + wc * 32 + 4 * fq;
    f32x4 cur[4], nxt[4];
    auto loadrow = [&](int row, f32x4 (&d)[4]) {
      const size_t off = (size_t)row * DM + col0;
      if (basef) {
#pragma unroll
        for (int q = 0; q < 4; ++q) d[q] = *(const f32x4*)(basef + off + (q >> 1) * 128 + (q & 1) * 16);
      } else {
#pragma unroll
        for (int q = 0; q < 4; ++q) { const u32x2 w = *(const u32x2*)(baseh + off + (q >> 1) * 128 + (q & 1) * 16); d[q] = (f32x4){bf_lo(w.x), bf_hi(w.x), bf_lo(w.y), bf_hi(w.y)}; }
      }
    };
    loadrow(row0, cur);
#pragma unroll
    for (int idx = 0; idx < 8; ++idx) {
      const int ai = idx >> 2, m = idx & 3;
      const int row = row0 + ai * 128 + m * 16;
      const size_t off = (size_t)row * DM + col0;
      if (idx + 1 < 8) loadrow(row0 + ((idx + 1) >> 2) * 128 + ((idx + 1) & 3) * 16, nxt);
      float ss = 0.f;
#pragma unroll
      for (int q = 0; q < 4; ++q) {
        const int bj = q >> 1, n = q & 1;
        const f32x4 o = cur[q] + acc[ai][bj][m][n];
        if (out) *(f32x4*)(out + off + bj * 128 + n * 16) = o;
        if (hb) { u32x2 w; w.x = cvt_pk_bf16(o[0], o[1]); w.y = cvt_pk_bf16(o[2], o[3]); *(u32x2*)(hb + off + bj * 128 + n * 16) = w; }
        if (ssq) ss += o[0] * o[0] + o[1] * o[1] + o[2] * o[2] + o[3] * o[3];
      }
      if (ssq) { ss += __shfl_xor(ss, 16); ss += __shfl_xor(ss, 32); if (fq == 0) atomicAdd(ssq + row, (u64_t)(ss * 1048576.f)); }
#pragma unroll
      for (int q = 0; q < 4; ++q) cur[q] = nxt[q];
    }
  }
};
struct EpiGate {
  static constexpr bool PERM = true;
  const bf16_t* xc; const float* ba; const float* bx; const float* sp8; bf16_t* la; bf16_t* bo;
  DI void operator()(const f32x4 (&acc)[2][2][4][2], const Unit& u, int wr, int wc, int fr, int fq) const {
    const int row0 = u.pm * 256 + wr * 64 + fr;
    const int ch0 = (u.pn >> 1) * 256 + (u.pn & 1) * 128 + wc * 32 + 8 * fq;
    float bav[8], bxv[8], spv[8];
    { const f32x4 a0 = *(const f32x4*)(ba + ch0), a1 = *(const f32x4*)(ba + ch0 + 4), x0 = *(const f32x4*)(bx + ch0), x1 = *(const f32x4*)(bx + ch0 + 4), s0 = *(const f32x4*)(sp8 + ch0), s1 = *(const f32x4*)(sp8 + ch0 + 4);
#pragma unroll
      for (int j = 0; j < 4; ++j) { bav[j] = a0[j]; bav[4 + j] = a1[j]; bxv[j] = x0[j]; bxv[4 + j] = x1[j]; spv[j] = s0[j]; spv[4 + j] = s1[j]; } }
    u32x4 xw = *(const u32x4*)(xc + (size_t)row0 * DM + ch0), xwn = xw;
#pragma unroll
    for (int idx = 0; idx < 8; ++idx) {
        const int ai = idx >> 2, m = idx & 3;
        const size_t off = (size_t)(row0 + ai * 128 + m * 16) * DM + ch0;
        if (idx + 1 < 8) xwn = *(const u32x4*)(xc + (size_t)(row0 + ((idx + 1) >> 2) * 128 + ((idx + 1) & 3) * 16) * DM + ch0);
        float xv[8]; xv[0] = bf_lo(xw.x); xv[1] = bf_hi(xw.x); xv[2] = bf_lo(xw.y); xv[3] = bf_hi(xw.y); xv[4] = bf_lo(xw.z); xv[5] = bf_hi(xw.z); xv[6] = bf_lo(xw.w); xv[7] = bf_hi(xw.w);
        float lav[8], bv[8];
#pragma unroll
        for (int n = 0; n < 2; ++n)
#pragma unroll
          for (int j = 0; j < 4; ++j) {
            const int e = 4 * n + j;
            const float r = __builtin_amdgcn_rcpf(1.f + __expf(-(acc[ai][0][m][n][j] + bav[e])));
            const float ig = __builtin_amdgcn_rcpf(1.f + __expf(-(acc[ai][1][m][n][j] + bxv[e])));
            const float l = -r * spv[e];
            const float x2 = 2.f * l;
            const float om = (x2 > -0.1f) ? -x2 * (1.f + x2 * (0.5f + x2 * (0.16666667f + x2 * 0.041666668f))) : 1.f - __expf(x2);
            lav[e] = l; bv[e] = sqrtf(om) * ig * xv[e];
          }
        u32x4 wl, wb;
        wl.x = cvt_pk_bf16(lav[0], lav[1]); wl.y = cvt_pk_bf16(lav[2], lav[3]); wl.z = cvt_pk_bf16(lav[4], lav[5]); wl.w = cvt_pk_bf16(lav[6], lav[7]);
        wb.x = cvt_pk_bf16(bv[0], bv[1]); wb.y = cvt_pk_bf16(bv[2], bv[3]); wb.z = cvt_pk_bf16(bv[4], bv[5]); wb.w = cvt_pk_bf16(bv[6], bv[7]);
        *(u32x4*)(la + off) = wl; *(u32x4*)(bo + off) = wb;
        xw = xwn;
      }
  }
};

struct CvtJob { const float* src; int ld_src; bf16_t* dst; int ld_dst; int perm; const float* gain; };
DI CvtJob cvt_decode(KParams P, int tile) {
  constexpr int NJ = 11;
  const int jK[NJ]  = {2048, 768, 512, 2048, 256, 2048, 2048, 2048, 8192, 2048, 8192};
  const int jNT[NJ] = {69, 24, 32, 32, 64, 32, 128, 64, 32, 128, 32};
  int j = 0, idx = tile;
#pragma unroll
  for (int jj = 0; jj < NJ - 1; ++jj) { const int cnt = (jK[jj] / 128) * jNT[jj]; if (j == jj && idx >= cnt) { idx -= cnt; j = jj + 1; } }
  int K = 2048;
  switch (j) { case 1: K = 768; break; case 2: K = 512; break; case 4: K = 256; break; case 8: case 10: K = 8192; break; default: break; }
  const int nkt = K / 128, kt = idx % nkt, ntile = idx / nkt, k0 = kt * 128, n0 = ntile * 64;
  const float* src; int ld_src; bf16_t* dst; int perm = 0; const float* gain = nullptr;
  switch (j) {
    case 0: src = P->w_in + (size_t)k0 * 4416 + n0; ld_src = 4416; dst = P->Wt_in; perm = (ntile == 68) ? 1 : 0; break;
    case 1: src = P->w_uq + (size_t)k0 * 1536 + n0; ld_src = 1536; dst = P->Wt_uq; perm = ((ntile % 3) == 2) ? 1 : 0; gain = P->q_norm + k0; break;
    case 2: src = P->w_ukv + (size_t)k0 * 2048 + n0; ld_src = 2048; dst = P->Wt_ukv; gain = P->kv_norm + k0; break;
    case 3: src = P->w_out + (size_t)k0 * 2048 + n0; ld_src = 2048; dst = P->Wt_out; break;
    case 4: { const int pn = n0 >> 8, rr = n0 & 255, blk = pn >> 1, half = pn & 1;
              src = (rr < 128 ? P->w_a : P->w_x) + (size_t)blk * 65536 + (size_t)k0 * 256 + half * 128 + (rr & 127); ld_src = 256; dst = P->Wt_gate; } break;
    case 5: src = P->rw_out + (size_t)k0 * 2048 + n0; ld_src = 2048; dst = P->Wt_rout; break;
    case 6: src = P->w1 + (size_t)2048 * 8192 + (size_t)k0 * 8192 + n0; ld_src = 8192; dst = P->Wt_w1 + (size_t)8192 * 2048; gain = P->norm_mlp + DM + k0; break;
    case 7: src = P->rw_in + (size_t)k0 * 4096 + n0; ld_src = 4096; dst = P->Wt_rin; gain = P->norm_mix + DM + k0; break;
    case 8: src = P->w2 + (size_t)8192 * 2048 + (size_t)k0 * 2048 + n0; ld_src = 2048; dst = P->Wt_w2 + (size_t)2048 * 8192; break;
    case 9: src = P->w1 + (size_t)k0 * 8192 + n0; ld_src = 8192; dst = P->Wt_w1; gain = P->norm_mlp + k0; break;
    default: src = P->w2 + (size_t)k0 * 2048 + n0; ld_src = 2048; dst = P->Wt_w2; break;
  }
  CvtJob jb; jb.src = src; jb.ld_src = ld_src; jb.dst = dst + (size_t)n0 * K + k0; jb.ld_dst = K; jb.perm = perm; jb.gain = gain; return jb;
}
constexpr int CVT_TOTAL = 16 * 69 + 6 * 24 + 4 * 32 + 16 * 32 + 16 * 64 + 2 * 64 + 16 * 32 + 16 * 128 + 16 * 128 + 64 * 32 + 64 * 32;
constexpr int CVT_S7 = 16 * 69 + 6 * 24 + 4 * 32 + 16 * 32 + 2 * 64 + 16 * 32 + 16 * 128;
constexpr int CVT_S8 = CVT_S7 + 16 * 64, CVT_S9 = CVT_S8 + 64 * 32;
constexpr int CVT_DEFER = 3072;
DI void convert_tiles(KParams P, LAS unsigned char* lds, int first, int stride, int total) {
  const int tid = tid_fresh(), kr = tid >> 4, c4 = tid & 15;
  f32x4 cur[4], nxt[4];
  int tile = first;
  CvtJob jb;
  if (tile < total) { jb = cvt_decode(P, tile);
#pragma unroll
    for (int p = 0; p < 2; ++p) { const int k = 64 * p + 2 * kr; cur[2 * p] = __builtin_nontemporal_load((const f32x4*)(jb.src + (size_t)k * jb.ld_src + 4 * c4)); cur[2 * p + 1] = __builtin_nontemporal_load((const f32x4*)(jb.src + (size_t)(k + 1) * jb.ld_src + 4 * c4)); } }
  int buf = 0;
  for (; tile < total; tile += stride) {
    const int ntile = tile + stride;
    CvtJob nj = jb;
    if (ntile < total) { nj = cvt_decode(P, ntile);
#pragma unroll
      for (int p = 0; p < 2; ++p) { const int k = 64 * p + 2 * kr; nxt[2 * p] = __builtin_nontemporal_load((const f32x4*)(nj.src + (size_t)k * nj.ld_src + 4 * c4)); nxt[2 * p + 1] = __builtin_nontemporal_load((const f32x4*)(nj.src + (size_t)(k + 1) * nj.ld_src + 4 * c4)); } }
    LAS unsigned char* L = lds + buf * 16896;
#pragma unroll
    for (int p = 0; p < 2; ++p) {
      const int k = 64 * p + 2 * kr;
      float g0 = 1.f, g1 = 1.f;
      if (jb.gain) { g0 = jb.gain[k]; g1 = jb.gain[k + 1]; }
#pragma unroll
      for (int i = 0; i < 4; ++i) {
        const int sc = 4 * c4 + i; const int n = jb.perm ? ((sc < 32) ? 2 * sc : 2 * (sc - 32) + 1) : sc;
        *(LAS unsigned*)(L + n * 264 + k * 2) = cvt_pk_bf16(cur[2 * p][i] * g0, cur[2 * p + 1][i] * g1);
      }
    }
    __syncthreads();
#pragma unroll
    for (int i = 0; i < 4; ++i) {
      const int pc = tid + 512 * i, n = pc >> 5, kc = pc & 31;
      const u32x2 v = *(const LAS u32x2*)(L + n * 264 + kc * 8);
      *(u32x2*)(jb.dst + (size_t)n * jb.ld_dst + kc * 4) = v;
    }
    buf ^= 1; jb = nj;
#pragma unroll
    for (int i = 0; i < 4; ++i) cur[i] = nxt[i];
  }
  __syncthreads();
}
DI void phase_convert(KParams P, LAS unsigned char* lds) {
  if (gridDim.x == 256) { convert_tiles(P, lds, blockIdx.x, 256, CVT_S7); convert_tiles(P, lds, CVT_S9 + blockIdx.x, 256, CVT_TOTAL - CVT_DEFER); }
  else convert_tiles(P, lds, blockIdx.x, gridDim.x, CVT_TOTAL);
  const int gtid = blockIdx.x * 512 + tid_fresh(), gsz = gridDim.x * 512;
  for (int i = gtid; i < T_TOK * 32; i += gsz) {
    const int t = i >> 5, f = i & 31;
    const float ang = (float)P->pos[t] * P->inv_freq[f];
    double rev = (double)ang * 0.15915494309189535; rev -= rint(rev);
    const float rf = (float)rev;
    P->cs[2 * i] = __builtin_amdgcn_cosf(rf); P->cs[2 * i + 1] = __builtin_amdgcn_sinf(rf);
  }
  for (int i = gtid; i < DM; i += gsz) P->sp8[i] = 8.f * log1pf(__expf(-P->rlam[i]));
  for (int i = gtid; i < 5 * T_TOK; i += gsz) P->ssq[i] = 0ull;
}

DI void phase_rmsnorm(const float* src, const float* g, bf16_t* dst, float* fout) {
  const int lane = tid_fresh() & 63, wid = tid_fresh() >> 6;
  f32x4 gv[8];
#pragma unroll
  for (int j = 0; j < 8; ++j) gv[j] = *(const f32x4*)(g + (j * 64 + lane) * 4);
  for (int row = blockIdx.x * 8 + wid; row < T_TOK; row += gridDim.x * 8) {
    const float* p = src + (size_t)row * DM;
    f32x4 v[8]; float ss = 0.f;
#pragma unroll
    for (int j = 0; j < 8; ++j) { v[j] = *(const f32x4*)(p + (j * 64 + lane) * 4); ss += v[j][0] * v[j][0] + v[j][1] * v[j][1] + v[j][2] * v[j][2] + v[j][3] * v[j][3]; }
    ss = wave_sum(ss);
    const float rs = rsqrtf(ss * (1.f / DM) + 1e-6f);
    if (fout) {
#pragma unroll
      for (int j = 0; j < 8; ++j) *(f32x4*)(fout + (size_t)row * DM + (j * 64 + lane) * 4) = v[j] * rs * gv[j];
    } else {
#pragma unroll
      for (int j = 0; j < 8; ++j) { const f32x4 o = v[j] * rs * gv[j]; u32x2 w; w.x = cvt_pk_bf16(o[0], o[1]); w.y = cvt_pk_bf16(o[2], o[3]); *(u32x2*)(dst + (size_t)row * DM + (j * 64 + lane) * 4) = w; }
    }
  }
}

DI void phase_prep(KParams P, bf16_t* lat) {
  const int lane = tid_fresh() & 63, wid = tid_fresh() >> 6;
  for (int row = blockIdx.x * 8 + wid; row < T_TOK; row += gridDim.x * 8) {
    bf16_t* p = lat + (size_t)row * 1536;
    u32x2 a[3], b[2]; float s1 = 0.f, s2 = 0.f;
#pragma unroll
    for (int j = 0; j < 3; ++j) { a[j] = *(const u32x2*)(p + (j * 64 + lane) * 4); const float x0 = bf_lo(a[j].x), x1 = bf_hi(a[j].x), x2 = bf_lo(a[j].y), x3 = bf_hi(a[j].y); s1 += x0 * x0 + x1 * x1 + x2 * x2 + x3 * x3; }
#pragma unroll
    for (int j = 0; j < 2; ++j) { b[j] = *(const u32x2*)(p + 768 + (j * 64 + lane) * 4); const float x0 = bf_lo(b[j].x), x1 = bf_hi(b[j].x), x2 = bf_lo(b[j].y), x3 = bf_hi(b[j].y); s2 += x0 * x0 + x1 * x1 + x2 * x2 + x3 * x3; }
    const float kr = bf2f(p[1280 + lane]);
    s1 = wave_sum(s1); s2 = wave_sum(s2);
    const float r1 = rsqrtf(s1 * (1.f / 768.f) + 1e-6f), r2 = rsqrtf(s2 * (1.f / 512.f) + 1e-6f);
#pragma unroll
    for (int j = 0; j < 3; ++j) { const f32x4 g = *(const f32x4*)(P->q_norm + (j * 64 + lane) * 4);
      u32x2 w; w.x = cvt_pk_bf16(bf_lo(a[j].x) * r1 * g[0], bf_hi(a[j].x) * r1 * g[1]); w.y = cvt_pk_bf16(bf_lo(a[j].y) * r1 * g[2], bf_hi(a[j].y) * r1 * g[3]); *(u32x2*)(p + (j * 64 + lane) * 4) = w; }
#pragma unroll
    for (int j = 0; j < 2; ++j) { const f32x4 g = *(const f32x4*)(P->kv_norm + (j * 64 + lane) * 4);
      u32x2 w; w.x = cvt_pk_bf16(bf_lo(b[j].x) * r2 * g[0], bf_hi(b[j].x) * r2 * g[1]); w.y = cvt_pk_bf16(bf_lo(b[j].y) * r2 * g[2], bf_hi(b[j].y) * r2 * g[3]); *(u32x2*)(p + 768 + (j * 64 + lane) * 4) = w; }
    const float other = __shfl_xor(kr, 32);
    const int i = lane & 31;
    const float c = P->cs[((size_t)row * 32 + i) * 2], s = P->cs[((size_t)row * 32 + i) * 2 + 1];
    const float o = (lane < 32) ? (kr * c - other * s) : (kr * c + other * s);
    p[1280 + 2 * i + (lane >> 5)] = (bf16_t)(cvt_pk_bf16(o, 0.f) & 0xffffu);
  }
}

DI void phase_conv(KParams P, const bf16_t* xr, bf16_t* xc) {
  for (int it = blockIdx.x * 512 + tid_fresh(); it < (T_TOK / 8) * 256; it += gridDim.x * 512) {
    const int chg = it & 255, tg = it >> 8, t0 = tg * 8, ch = chg * 8;
    float w[4][8], bias[8];
#pragma unroll
    for (int j = 0; j < 4; ++j) { const f32x4 a = *(const f32x4*)(P->conv_w + j * DM + ch), b = *(const f32x4*)(P->conv_w + j * DM + ch + 4);
#pragma unroll
      for (int e = 0; e < 4; ++e) { w[j][e] = a[e]; w[j][4 + e] = b[e]; } }
    { const f32x4 a = *(const f32x4*)(P->conv_b + ch), b = *(const f32x4*)(P->conv_b + ch + 4);
#pragma unroll
      for (int e = 0; e < 4; ++e) { bias[e] = a[e]; bias[4 + e] = b[e]; } }
    float win[3][8];
    const bool first = (t0 & (SEQ - 1)) == 0;
#pragma unroll
    for (int j = 0; j < 3; ++j) {
      u32x4 v = (u32x4){0u, 0u, 0u, 0u};
      if (!first) v = *(const u32x4*)(xr + (size_t)(t0 - 3 + j) * DM + ch);
      win[j][0] = bf_lo(v.x); win[j][1] = bf_hi(v.x); win[j][2] = bf_lo(v.y); win[j][3] = bf_hi(v.y); win[j][4] = bf_lo(v.z); win[j][5] = bf_hi(v.z); win[j][6] = bf_lo(v.w); win[j][7] = bf_hi(v.w);
    }
#pragma unroll
    for (int t = 0; t < 8; ++t) {
      const u32x4 v = *(const u32x4*)(xr + (size_t)(t0 + t) * DM + ch);
      float cur[8]; cur[0] = bf_lo(v.x); cur[1] = bf_hi(v.x); cur[2] = bf_lo(v.y); cur[3] = bf_hi(v.y); cur[4] = bf_lo(v.z); cur[5] = bf_hi(v.z); cur[6] = bf_lo(v.w); cur[7] = bf_hi(v.w);
      float o[8];
#pragma unroll
      for (int e = 0; e < 8; ++e) o[e] = bias[e] + w[0][e] * win[0][e] + w[1][e] * win[1][e] + w[2][e] * win[2][e] + w[3][e] * cur[e];
      u32x4 wv; wv.x = cvt_pk_bf16(o[0], o[1]); wv.y = cvt_pk_bf16(o[2], o[3]); wv.z = cvt_pk_bf16(o[4], o[5]); wv.w = cvt_pk_bf16(o[6], o[7]);
      *(u32x4*)(xc + (size_t)(t0 + t) * DM + ch) = wv;
#pragma unroll
      for (int e = 0; e < 8; ++e) { win[0][e] = win[1][e]; win[1][e] = win[2][e]; win[2][e] = cur[e]; }
    }
  }
}

DI void unpack8(const u32x4 v, float* f) { f[0] = bf_lo(v.x); f[1] = bf_hi(v.x); f[2] = bf_lo(v.y); f[3] = bf_hi(v.y); f[4] = bf_lo(v.z); f[5] = bf_hi(v.z); f[6] = bf_lo(v.w); f[7] = bf_hi(v.w); }
DI void phase_scan1(const bf16_t* la, const bf16_t* bb, float* asum, float* hend) {
  for (int it = blockIdx.x * 512 + tid_fresh(); it < NB * 128 * 256; it += gridDim.x * 512) {
    const int chg = it & 255, c = (it >> 8) & 127, b = it >> 15;
    const size_t base = ((size_t)b * SEQ + c * 32) * DM + chg * 8;
    float h[8], as[8];
#pragma unroll
    for (int e = 0; e < 8; ++e) { h[e] = 0.f; as[e] = 0.f; }
#pragma unroll 8
    for (int t = 0; t < 32; ++t) {
      float l[8], bv[8]; unpack8(*(const u32x4*)(la + base + (size_t)t * DM), l); unpack8(*(const u32x4*)(bb + base + (size_t)t * DM), bv);
#pragma unroll
      for (int e = 0; e < 8; ++e) { h[e] = __expf(l[e]) * h[e] + bv[e]; as[e] += l[e]; }
    }
    const size_t so = ((size_t)b * 128 + c) * DM + chg * 8;
    *(f32x4*)(asum + so) = (f32x4){as[0], as[1], as[2], as[3]}; *(f32x4*)(asum + so + 4) = (f32x4){as[4], as[5], as[6], as[7]};
    *(f32x4*)(hend + so) = (f32x4){h[0], h[1], h[2], h[3]}; *(f32x4*)(hend + so + 4) = (f32x4){h[4], h[5], h[6], h[7]};
  }
}
DI void phase_scan_carry(const float* asum, float* hend) {
  for (int it = blockIdx.x * 512 + tid_fresh(); it < NB * DM; it += gridDim.x * 512) {
    const int ch = it & (DM - 1), b = it >> 11;
    float H = 0.f;
    for (int c0 = 0; c0 < 128; c0 += 16) {
      float a[16], he[16];
#pragma unroll
      for (int i = 0; i < 16; ++i) { const size_t o = ((size_t)b * 128 + c0 + i) * DM + ch; a[i] = asum[o]; he[i] = hend[o]; }
#pragma unroll
      for (int i = 0; i < 16; ++i) { const size_t o = ((size_t)b * 128 + c0 + i) * DM + ch; hend[o] = H; H = __expf(a[i]) * H + he[i]; }
    }
  }
}
DI void phase_scan2(const bf16_t* la, const bf16_t* bb, const bf16_t* y, const float* hin, bf16_t* yh) {
  for (int it = blockIdx.x * 512 + tid_fresh(); it < NB * 128 * 256; it += gridDim.x * 512) {
    const int chg = it & 255, c = (it >> 8) & 127, b = it >> 15;
    const size_t base = ((size_t)b * SEQ + c * 32) * DM + chg * 8;
    const size_t so = ((size_t)b * 128 + c) * DM + chg * 8;
    float h[8];
    { const f32x4 a = *(const f32x4*)(hin + so), bq = *(const f32x4*)(hin + so + 4);
#pragma unroll
      for (int e = 0; e < 4; ++e) { h[e] = a[e]; h[4 + e] = bq[e]; } }
#pragma unroll 8
    for (int t = 0; t < 32; ++t) {
      float l[8], bv[8], yv[8]; unpack8(*(const u32x4*)(la + base + (size_t)t * DM), l); unpack8(*(const u32x4*)(bb + base + (size_t)t * DM), bv); unpack8(*(const u32x4*)(y + base + (size_t)t * DM), yv);
      float o[8];
#pragma unroll
      for (int e = 0; e < 8; ++e) { h[e] = __expf(l[e]) * h[e] + bv[e]; o[e] = h[e] * yv[e]; }
      u32x4 wv; wv.x = cvt_pk_bf16(o[0], o[1]); wv.y = cvt_pk_bf16(o[2], o[3]); wv.z = cvt_pk_bf16(o[4], o[5]); wv.w = cvt_pk_bf16(o[6], o[7]);
      *(u32x4*)(yh + base + (size_t)t * DM) = wv;
    }
  }
}

DI void glds16(const void* gsrc, unsigned lds_dst) { unsigned keep;
  asm volatile("s_mov_b32 %0, m0\n\ts_mov_b32 m0, %2\n\ts_nop 0\n\tglobal_load_lds_dwordx4 %1, off\n\ts_mov_b32 m0, %0" : "=&s"(keep) : "v"(gsrc), "s"(lds_dst) : "memory"); }
struct AttnSrc {
  const bf16_t* q; int ldq;
  const bf16_t* k0; int ldk0; int nk0;
  const bf16_t* k1; int ldk1;
  const bf16_t* v; int ldv;
};
template <int DK>
DI void attn_pass(const AttnSrc& s, const int q0, const float sc, LAS unsigned char* lds, f32x16 (&O)[4]) {
  constexpr int ROWB = DK * 2, KSZ = 64 * ROWB, VSZ = 16384, KP = KSZ / 8192, NS = DK / 16, STG = KSZ + VSZ, NBUF = (DK == 64) ? 4 : 3, DPF = NBUF - 1, PT = KP + 2;
  const int tid = tid_fresh(), lane = tid & 63, wid = __builtin_amdgcn_readfirstlane(tid >> 6), r = lane & 31, h = lane >> 5;
  const int qw0 = q0 + wid * 32;
  asm volatile("s_waitcnt vmcnt(0)" ::: "memory");
#pragma unroll
  for (int i = 0; i < 4; ++i)
#pragma unroll
    for (int j = 0; j < 16; ++j) O[i][j] = 0.f;
  float mrun = (DK == 64) ? 0.f : -INFINITY, lrun = 0.f;
  const int NT = (q0 + 256) / 64;
  const bf16_t* kp[KP]; int kstr[KP]; const bf16_t* vp[2];
#pragma unroll
  for (int i = 0; i < KP; ++i) {
    const int o = (wid + 8 * i) * 1024 + lane * 16, row = o / ROWB, pc = (o % ROWB) >> 4;
    const int lc = (DK == 64) ? (pc ^ (row & 7)) : ((pc & ~7) | ((pc & 7) ^ ((row >> 1) & 7)));
    const int e = lc * 8;
    if (e < s.nk0) { kp[i] = s.k0 + (size_t)row * s.ldk0 + e; kstr[i] = 64 * s.ldk0; } else { kp[i] = s.k1 + (size_t)row * s.ldk1 + (e - s.nk0); kstr[i] = 64 * s.ldk1; }
  }
#pragma unroll
  for (int i = 0; i < 2; ++i) {
    const int o = (wid + 8 * i) * 1024 + lane * 16, row = o >> 8, pc = (o >> 4) & 15;
    const int lc = (((pc >> 2) ^ (row & 3)) << 2) | (pc & 3);
    vp[i] = s.v + (size_t)row * s.ldv + lc * 8;
  }
  const int vstr = 64 * s.ldv;
  const unsigned lds0 = (unsigned)reinterpret_cast<__UINTPTR_TYPE__>(lds);
  auto issue = [&](int t, int buf) {
#pragma unroll
    for (int i = 0; i < KP; ++i) glds16(kp[i] + (size_t)t * kstr[i], (unsigned)__builtin_amdgcn_readfirstlane(lds0 + buf * STG + (wid + 8 * i) * 1024));
#pragma unroll
    for (int i = 0; i < 2; ++i) glds16(vp[i] + (size_t)t * vstr, (unsigned)__builtin_amdgcn_readfirstlane(lds0 + buf * STG + KSZ + (wid + 8 * i) * 1024));
  };
#pragma unroll
  for (int i = 0; i < DPF; ++i) issue(i, i);
  bf16x8 qf[NS];
#pragma unroll
  for (int i = 0; i < NS; ++i) qf[i] = *(const bf16x8*)(s.q + (size_t)(qw0 + r) * s.ldq + 16 * i + 8 * h);
#pragma unroll
  for (int i = 0; i < NS; ++i) asm volatile("" : "+v"(qf[i]));
  constexpr bool REL = (DK == 64);
  if (REL) {
#pragma unroll
  for (int i = 0; i < NS; ++i) {
    const u32x4 w = __builtin_bit_cast(u32x4, qf[i]); u32x4 o;
    o.x = cvt_pk_bf16(bf_lo(w.x) * sc, bf_hi(w.x) * sc); o.y = cvt_pk_bf16(bf_lo(w.y) * sc, bf_hi(w.y) * sc);
    o.z = cvt_pk_bf16(bf_lo(w.z) * sc, bf_hi(w.z) * sc); o.w = cvt_pk_bf16(bf_lo(w.w) * sc, bf_hi(w.w) * sc);
    qf[i] = __builtin_bit_cast(bf16x8, o);
  }
  }
  f32x16 negm;
#pragma unroll
  for (int j = 0; j < 16; ++j) negm[j] = 0.f;
  if (REL) asm volatile("" : "+v"(negm));
  const int kx = (DK == 64) ? (r & 7) : ((r >> 1) & 7);
  const int krow = r * ROWB;
  const int i15 = lane & 15;
  const int vrow = (4 * h + (i15 >> 2)) * 256 + ((lane >> 4) & 1) * 32 + (lane & 3) * 8;
  const int vx = (i15 >> 2) & 3;
  int buf = 0, pbuf = DPF;
  for (int t = 0; t < NT; ++t) {
    { const int rem = NT - 1 - t;
      if (rem >= DPF - 1) asm volatile("s_waitcnt vmcnt(%0)" :: "n"((DPF - 1) * PT) : "memory");
      else if (rem == 1) asm volatile("s_waitcnt vmcnt(%0)" :: "n"(PT) : "memory");
      else asm volatile("s_waitcnt vmcnt(0)" ::: "memory"); }
    __builtin_amdgcn_s_barrier();
    asm volatile("" ::: "memory");
    if (t + DPF < NT) issue(t + DPF, pbuf);
    if (64 * t <= qw0 + 31) {
      LAS unsigned char* Kb = lds + buf * STG; LAS unsigned char* Vb = lds + buf * STG + KSZ;
      f32x16 p0, p1;
      constexpr int GS = (DK == 64) ? 4 : 2, NG = NS / GS;
      bf16x8 kfa[2][GS], kfb[2][GS];
      auto kload = [&](int g, int slot) {
#pragma unroll
        for (int j = 0; j < GS; ++j) { const int lc = 2 * (g * GS + j) + h; const int ph = (DK == 64) ? (lc ^ kx) : ((lc & ~7) | ((lc & 7) ^ kx));
          kfa[slot][j] = *(const LAS bf16x8*)(Kb + krow + ph * 16); kfb[slot][j] = *(const LAS bf16x8*)(Kb + krow + 32 * ROWB + ph * 16); }
      };
      kload(0, 0);
#pragma unroll
      for (int g = 0; g < NG; ++g) {
        if (g + 1 < NG) kload(g + 1, (g + 1) & 1);
        __builtin_amdgcn_s_setprio(1);
#pragma unroll
        for (int j = 0; j < GS; ++j) {
          if (g == 0 && j == 0) {
            if (REL) {
              p0 = __builtin_amdgcn_mfma_f32_32x32x16_bf16(kfa[0][0], qf[0], negm, 0, 0, 0);
              p1 = __builtin_amdgcn_mfma_f32_32x32x16_bf16(kfb[0][0], qf[0], negm, 0, 0, 0);
            } else {
              f32x16 z;
#pragma unroll
              for (int jj = 0; jj < 16; ++jj) z[jj] = 0.f;
              p0 = __builtin_amdgcn_mfma_f32_32x32x16_bf16(kfa[0][0], qf[0], z, 0, 0, 0);
              p1 = __builtin_amdgcn_mfma_f32_32x32x16_bf16(kfb[0][0], qf[0], z, 0, 0, 0);
            }
          } else {
            p0 = __builtin_amdgcn_mfma_f32_32x32x16_bf16(kfa[g & 1][j], qf[g * GS + j], p0, 0, 0, 0);
            p1 = __builtin_amdgcn_mfma_f32_32x32x16_bf16(kfb[g & 1][j], qf[g * GS + j], p1, 0, 0, 0);
          }
        }
        __builtin_amdgcn_s_setprio(0);
      }
      bf16x8 vf[2][4];
      auto vload = [&](int vt, int slot) {
        const int vcol = vrow + ((vt ^ vx) << 6);
#pragma unroll
        for (int ks = 0; ks < 4; ++ks) {
          const s16x4 lo = __builtin_bit_cast(s16x4, __builtin_amdgcn_ds_read_tr16_b64_v4i16((LAS s16x4*)(Vb + vcol + ks * 16 * 256)));
          const s16x4 hi = __builtin_bit_cast(s16x4, __builtin_amdgcn_ds_read_tr16_b64_v4i16((LAS s16x4*)(Vb + vcol + (ks * 16 + 8) * 256)));
          vf[slot][ks] = __builtin_shufflevector(lo, hi, 0, 1, 2, 3, 4, 5, 6, 7);
        }
      };
      vload(0, 0);
      if (64 * t + 63 > qw0) {
        const int qa = qw0 + r, kbase = 64 * t + 4 * h;
#pragma unroll
        for (int j = 0; j < 16; ++j) { const int kv = kbase + (j & 3) + 8 * (j >> 2); if (kv > qa) p0[j] = -INFINITY; if (kv + 32 > qa) p1[j] = -INFINITY; }
      }
      float mx = fmaxf(p0[0], p1[0]);
#pragma unroll
      for (int j = 1; j < 16; ++j) mx = fmaxf(mx, fmaxf(p0[j], p1[j]));
      { auto rr = __builtin_amdgcn_permlane32_swap(__float_as_uint(mx), __float_as_uint(mx), false, false); mx = fmaxf(__uint_as_float(rr[0]), __uint_as_float(rr[1])); }
      float rs = 0.f;
      if (REL) {
        const bool grow = (mx > 8.f) || (t == 0);
        if (__builtin_amdgcn_ballot_w64(grow) != 0ull) {
          const float dl = grow ? mx : 0.f;
          const float alpha = __builtin_amdgcn_exp2f(-dl);
          mrun += dl; lrun *= alpha;
#pragma unroll
          for (int j = 0; j < 16; ++j) { p0[j] -= dl; p1[j] -= dl; negm[j] = -mrun; }
          asm volatile("" : "+v"(negm));
#pragma unroll
          for (int i = 0; i < 4; ++i)
#pragma unroll
            for (int j = 0; j < 16; ++j) O[i][j] *= alpha;
        }
#pragma unroll
        for (int j = 0; j < 16; ++j) { p0[j] = __builtin_amdgcn_exp2f(p0[j]); p1[j] = __builtin_amdgcn_exp2f(p1[j]); rs += p0[j] + p1[j]; }
      } else {
        const float cand = mx * sc;
        const bool grow = cand > mrun + 8.f;
        if (__builtin_amdgcn_ballot_w64(grow) != 0ull) {
          const float mnew = grow ? cand : mrun;
          const float alpha = __builtin_amdgcn_exp2f(mrun - mnew);
          mrun = mnew; lrun *= alpha;
#pragma unroll
          for (int i = 0; i < 4; ++i)
#pragma unroll
            for (int j = 0; j < 16; ++j) O[i][j] *= alpha;
        }
#pragma unroll
        for (int j = 0; j < 16; ++j) { p0[j] = __builtin_amdgcn_exp2f(p0[j] * sc - mrun); p1[j] = __builtin_amdgcn_exp2f(p1[j] * sc - mrun); rs += p0[j] + p1[j]; }
      }
      lrun += rs;
      bf16x8 pb[4];
      { u32x4 w;
        w.x = cvt_pk_bf16(p0[0], p0[1]); w.y = cvt_pk_bf16(p0[2], p0[3]); w.z = cvt_pk_bf16(p0[4], p0[5]); w.w = cvt_pk_bf16(p0[6], p0[7]); pb[0] = __builtin_bit_cast(bf16x8, w);
        w.x = cvt_pk_bf16(p0[8], p0[9]); w.y = cvt_pk_bf16(p0[10], p0[11]); w.z = cvt_pk_bf16(p0[12], p0[13]); w.w = cvt_pk_bf16(p0[14], p0[15]); pb[1] = __builtin_bit_cast(bf16x8, w);
        w.x = cvt_pk_bf16(p1[0], p1[1]); w.y = cvt_pk_bf16(p1[2], p1[3]); w.z = cvt_pk_bf16(p1[4], p1[5]); w.w = cvt_pk_bf16(p1[6], p1[7]); pb[2] = __builtin_bit_cast(bf16x8, w);
        w.x = cvt_pk_bf16(p1[8], p1[9]); w.y = cvt_pk_bf16(p1[10], p1[11]); w.z = cvt_pk_bf16(p1[12], p1[13]); w.w = cvt_pk_bf16(p1[14], p1[15]); pb[3] = __builtin_bit_cast(bf16x8, w); }
#pragma unroll
      for (int vt = 0; vt < 4; ++vt) {
        if (vt + 1 < 4) vload(vt + 1, (vt + 1) & 1);
        __builtin_amdgcn_s_setprio(1);
#pragma unroll
        for (int ks = 0; ks < 4; ++ks) O[vt] = __builtin_amdgcn_mfma_f32_32x32x16_bf16(vf[vt & 1][ks], pb[ks], O[vt], 0, 0, 0);
        __builtin_amdgcn_s_setprio(0);
      }
    }
    buf = (buf + 1 == NBUF) ? 0 : buf + 1; pbuf = (pbuf + 1 == NBUF) ? 0 : pbuf + 1;
  }
  asm volatile("s_waitcnt lgkmcnt(0)" ::: "memory");
  __builtin_amdgcn_s_barrier();
  asm volatile("" ::: "memory");
  float lt; { auto rr = __builtin_amdgcn_permlane32_swap(__float_as_uint(lrun), __float_as_uint(lrun), false, false); lt = __uint_as_float(rr[0]) + __uint_as_float(rr[1]); }
  const float inv = 1.f / lt;
#pragma unroll
  for (int i = 0; i < 4; ++i)
#pragma unroll
    for (int j = 0; j < 16; ++j) O[i][j] *= inv;
}

DI void attn_store(const f32x16 (&O)[4], bf16_t* dst, int qrow, int h) {
#pragma unroll
  for (int vt = 0; vt < 4; ++vt)
#pragma unroll
    for (int g = 0; g < 4; ++g) {
      u32x2 w; w.x = cvt_pk_bf16(O[vt][4 * g], O[vt][4 * g + 1]); w.y = cvt_pk_bf16(O[vt][4 * g + 2], O[vt][4 * g + 3]);
      *(u32x2*)(dst + (size_t)qrow * DM + 32 * vt + 8 * g + 4 * h) = w;
    }
}

DI void phase_attention(KParams P, LAS unsigned char* lds) {
  const bf16_t* qkva = P->X; const bf16_t* lat = P->X + (size_t)T_TOK * 3072; const bf16_t* qb_ = lat + (size_t)T_TOK * 1536; const bf16_t* kv = qb_ + (size_t)T_TOK * 1536;
  const int lane = tid_fresh() & 63, wid = tid_fresh() >> 6, r = lane & 31, h = lane >> 5;
  float lam;
  { const float s1 = wave_sum(P->lq1[lane] * P->lk1[lane]), s2 = wave_sum(P->lq2[lane] * P->lk2[lane]); lam = __expf(s1) - __expf(s2) + 0.2f; }
  const int G = gridDim.x;
  const int vb = ((int)blockIdx.x % 8) * (G / 8) + (int)blockIdx.x / 8;
  const float LOG2E = 1.4426950408889634f;
#ifndef ATTN_NO_A
  for (int it = vb; it < 256; it += G) {
    const int bh = it >> 3, sidx = it & 7, b = bh >> 3, head = bh & 7;
#pragma unroll 1
    for (int half = 0; half < 2; ++half) {
      const int qb = half ? 15 - sidx : sidx, q0 = qb * 256;
      const size_t rb = (size_t)b * SEQ;
      unsigned o1p[4][8];
      f32x16 O[4];
#pragma unroll 1
      for (int map = 0; map < 2; ++map) {
        AttnSrc s;
        s.q = qkva + rb * 3072 + head * 128 + map * 64; s.ldq = 3072;
        s.k0 = qkva + rb * 3072 + 1024 + head * 128 + map * 64; s.ldk0 = 3072; s.nk0 = 64; s.k1 = s.k0; s.ldk1 = 3072;
        s.v = qkva + rb * 3072 + 2048 + head * 128; s.ldv = 3072;
        attn_pass<64>(s, q0, 0.125f * LOG2E, lds, O);
        if (map == 0) {
#pragma unroll
          for (int i = 0; i < 4; ++i)
#pragma unroll
            for (int j = 0; j < 8; ++j) o1p[i][j] = cvt_pk_bf16(O[i][2 * j], O[i][2 * j + 1]);
        }
      }
      float ss = 0.f;
#pragma unroll
      for (int i = 0; i < 4; ++i)
#pragma unroll
        for (int j = 0; j < 8; ++j) { const float a = bf_lo(o1p[i][j]) - lam * O[i][2 * j], c = bf_hi(o1p[i][j]) - lam * O[i][2 * j + 1]; O[i][2 * j] = a; O[i][2 * j + 1] = c; ss += a * a + c * c; }
      ss += __shfl_xor(ss, 32);
      const float rs = rsqrtf(ss * (1.f / 128.f) + 1e-5f) * 0.8f;
#pragma unroll
      for (int i = 0; i < 4; ++i)
#pragma unroll
        for (int g = 0; g < 4; ++g) { const f32x4 gn = *(const f32x4*)(P->subln + 32 * i + 8 * g + 4 * h);
#pragma unroll
          for (int e = 0; e < 4; ++e) O[i][4 * g + e] *= rs * gn[e]; }
      attn_store(O, P->act + rb * DM + head * 128, q0 + wid * 32 + r, h);
    }
  }
#endif
#ifndef ATTN_NO_B
  for (int it = vb; it < 256; it += G) {
    const int bh = it >> 3, sidx = it & 7, b = bh >> 3, head = bh & 7;
#pragma unroll 1
    for (int half = 0; half < 2; ++half) {
      const int qb = half ? 15 - sidx : sidx, q0 = qb * 256;
      const size_t rb = (size_t)b * SEQ;
      f32x16 O[4];
      AttnSrc s;
      s.q = qb_ + rb * 1536 + head * 192; s.ldq = 1536;
      s.k0 = kv + rb * 2048 + head * 256; s.ldk0 = 2048; s.nk0 = 128; s.k1 = lat + rb * 1536 + 1280; s.ldk1 = 1536;
      s.v = kv + rb * 2048 + head * 256 + 128; s.ldv = 2048;
      attn_pass<192>(s, q0, 0.07216878364870322f * LOG2E, lds, O);
      attn_store(O, P->act + rb * DM + 1024 + head * 128, q0 + wid * 32 + r, h);
    }
  }
#endif
}

#define XB_TMO      128
#define XB_XCNT(j)  (256  + 64 * (j))
#define XB_XSUB(j)  (1280 + 64 * (j))
#define XB_XGEN(j)  (2304 + 64 * (j))
#define XB_TOP      3328
#define XB_TOPGEN   3392
#define XCD_BAR_WORDS 3456
#define XB_SPIN_CAP (1u << 18)

__device__ __forceinline__ unsigned xb_ld(unsigned* p)              { return __hip_atomic_load(p, __ATOMIC_RELAXED, __HIP_MEMORY_SCOPE_AGENT); }
__device__ __forceinline__ unsigned xb_add(unsigned* p, unsigned v) { return __hip_atomic_fetch_add(p, v, __ATOMIC_RELAXED, __HIP_MEMORY_SCOPE_AGENT); }
__device__ __forceinline__ unsigned xb_xcc_id() { return (unsigned)__builtin_amdgcn_s_getreg((3 << 11) | 20) & 0xFu; }
#define XB_SPIN(cond, bar) do { unsigned _sp = 0; while (cond) { __builtin_amdgcn_s_sleep(1); \
    if ((++_sp & 255u) == 0u) { if (xb_ld(&(bar)[XB_TMO])) break; if (_sp > XB_SPIN_CAP) { atomicAdd(&(bar)[XB_TMO], 1u); break; } } } } while (0)

struct XcdBarrier {
    unsigned* bar; unsigned x;
    volatile LAS unsigned* st;
};

__device__ __forceinline__ XcdBarrier xcd_barrier_post(unsigned* bar, volatile LAS unsigned* st) {
    XcdBarrier b; b.bar = bar; b.x = xb_xcc_id(); b.st = st;
    if (threadIdx.x == 0) (void)xb_add(&bar[XB_XCNT(b.x)], 1u);
    return b;
}
__device__ __forceinline__ void xcd_barrier_complete(unsigned* bar, unsigned x, unsigned& nloc, unsigned& nx) {
    const unsigned G = gridDim.x * gridDim.y * gridDim.z;
    unsigned sum, cnt, mine, sp = 0u;
    for (;;) {
        sum = 0u; cnt = 0u; mine = 0u;
#pragma unroll
        for (unsigned j = 0; j < 16; ++j) { const unsigned c = xb_ld(&bar[XB_XCNT(j)]); sum += c; cnt += (c > 0u) ? 1u : 0u; mine = (j == x) ? c : mine; }
        if (sum == G) break;
        __builtin_amdgcn_s_sleep(1);
        if ((++sp & 255u) == 0u) { if (xb_ld(&bar[XB_TMO])) break; if (sp > XB_SPIN_CAP) { atomicAdd(&bar[XB_TMO], 1u); break; } }
    }
    nloc = mine > 0u ? mine : 1u; nx = cnt > 0u ? cnt : 1u;
}

__device__ __forceinline__ void xcd_barrier(const XcdBarrier& b) {
    asm volatile("s_waitcnt vmcnt(0)" ::: "memory");
    __syncthreads();
    if (threadIdx.x == 0) {
        unsigned* bar = b.bar;
        __builtin_amdgcn_s_waitcnt(0);
        unsigned nloc = b.st[0], nx = b.st[1];
        if (nloc == 0u) { xcd_barrier_complete(bar, b.x, nloc, nx); b.st[0] = nloc; b.st[1] = nx; }
        const unsigned old = xb_add(&bar[XB_XSUB(b.x)], 1u);
        const unsigned gen = old / nloc;
        if (old + 1u == (gen + 1u) * nloc) {
            __builtin_amdgcn_fence(__ATOMIC_RELEASE, "agent");
            asm volatile("s_waitcnt vmcnt(0)" ::: "memory");
            const unsigned og = xb_add(&bar[XB_TOP], 1u);
            const unsigned tg = og / nx;
            if (og + 1u == (tg + 1u) * nx) xb_add(&bar[XB_TOPGEN], 1u);
            else XB_SPIN(xb_ld(&bar[XB_TOPGEN]) == tg, bar);
            __builtin_amdgcn_fence(__ATOMIC_ACQUIRE, "agent");
            xb_add(&bar[XB_XGEN(b.x)], 1u);
            asm volatile("s_waitcnt vmcnt(0)" ::: "memory");
        } else {
            XB_SPIN(xb_ld(&bar[XB_XGEN(b.x)]) == gen, bar);
            __builtin_amdgcn_fence(__ATOMIC_ACQUIRE, "agent");
            asm volatile("s_waitcnt vmcnt(0)" ::: "memory");
        }
    }
    __syncthreads();
}


constexpr int NSTEP = 22;
__global__ void __launch_bounds__(512, 2) fwd_kernel(Params Parg) {
  extern __shared__ __attribute__((aligned(16))) unsigned char shm[];
  LAS unsigned char* lds = (LAS unsigned char*)shm;
  KParams Pk = (KParams)__builtin_amdgcn_kernarg_segment_ptr();
  const int step_lo = Pk->step_lo, step_hi = Pk->step_hi;
  volatile LAS unsigned* xst = (volatile LAS unsigned*)(lds + LDS_BYTES);
  if (threadIdx.x == 0) { xst[0] = 0u; xst[1] = 0u; }
  __syncthreads();
  const XcdBarrier xb = xcd_barrier_post(Pk->bar, xst);
#ifndef REPEAT_MASK
#define REPEAT_MASK 0
#endif
#ifndef EXTRA_SYNCS
#define EXTRA_SYNCS 0
#endif
  for (int st2 = 2 * step_lo; st2 < 2 * step_hi; ++st2) {
    const int st = st2 >> 1;
    if ((st2 & 1) && !((REPEAT_MASK >> st) & 1)) continue;
    if (EXTRA_SYNCS && st2 == 2 * step_lo) { for (int i = 0; i < EXTRA_SYNCS; ++i) cg::this_grid().sync(); }
    KParams Pl = Pk; asm volatile("" : "+s"(Pl));
    bool sync_after = true;
    const int gi = Pl->step_gd[st];
    if (gi == -2) continue;
    if (gi >= 0) {
      if (EN(100 + 1) || EN(100 + 2) || EN(100 + 3)) {
      const __attribute__((address_space(4))) GD& d = Pl->gd[gi];
      Gemm g{d.A, d.Bt, d.M, d.N, d.K, d.lda, d.ldb, d.gate};
      StaticOrder S; S.init(g.M, g.N, (int)gridDim.x, (int)blockIdx.x);
      if (d.kind == 1) { if (EN(101)) { EpiBf e{(bf16_t*)d.p0, d.ld0, (bf16_t*)d.p1, d.ld1, d.split, d.mode, (const float*)d.q0, (const u64_t*)d.q1, __int_as_float(d.pad), (u64_t*)d.q2, (u64_t*)d.q3}; pg8::gemm_phase<EpiBf>(lds, g, S, e); } }
      else if (d.kind == 2) { if (EN(102)) { EpiRes e{(const float*)d.q0, (const bf16_t*)d.q2, (float*)d.p0, (bf16_t*)d.p1, (u64_t*)d.q1}; pg8::gemm_phase<EpiRes>(lds, g, S, e); } }
      else { if (EN(103)) { EpiGate e{(const bf16_t*)d.q0, (const float*)d.q1, (const float*)d.q2, (const float*)d.q3, (bf16_t*)d.p0, (bf16_t*)d.p1}; pg8::gemm_phase<EpiGate>(lds, g, S, e); } }
      }
      if (st == 1 && gridDim.x == 256 && blockIdx.x >= 128)
        convert_tiles(Pl, lds, CVT_TOTAL - CVT_DEFER + ((int)blockIdx.x - 128), 128, CVT_TOTAL);
      if (st == 4 && gridDim.x == 256 && blockIdx.x >= 128)
        convert_tiles(Pl, lds, CVT_S7 + ((int)blockIdx.x - 128), 128, CVT_S8);
      if (st == 3) sync_after = false;
    } else {
      KParams P = Pl;
      bf16_t* const X = P->X;
      bf16_t* const lat = X + (size_t)T_TOK * 3072;
      bf16_t* const ybuf = X; bf16_t* const xr = X + (size_t)T_TOK * DM; bf16_t* const labuf = xr + (size_t)T_TOK * DM; bf16_t* const bbuf = (bf16_t*)P->out;
      float* const asum = (float*)xr; float* const hend = asum + (size_t)NB * 128 * DM;
      const int layer = (st >= 10) ? 1 : 0;
      switch (st) {
        case 0: if (EN(0)) { phase_convert(P, lds); phase_rmsnorm(P->x, P->norm_mix, P->act, nullptr); } break;
        case 2: if (EN(2)) phase_prep(P, lat); break;
        case 5: if (EN(5)) phase_attention(P, lds); break;
        case 7: case 18: if (EN(7)) phase_rmsnorm(P->out, P->norm_mlp + layer * DM, P->act, nullptr); break;
        case 10: if (EN(7)) phase_rmsnorm(P->out, P->norm_mix + DM, P->act, nullptr); break;
        case 12: if (EN(12)) phase_conv(P, xr, P->act); break;
        case 14: if (EN(14)) phase_scan1(labuf, bbuf, asum, hend); break;
        case 15: if (EN(15)) { phase_scan_carry(asum, hend);
                               if (gridDim.x == 256 && blockIdx.x >= 16) convert_tiles(P, lds, CVT_S8 + ((int)blockIdx.x - 16), 240, CVT_S9); } break;
        case 16: if (EN(16)) phase_scan2(labuf, bbuf, ybuf, hend, P->act); break;
        case 21: if (EN(7)) phase_rmsnorm(P->out, P->norm_final, nullptr, P->out); break;
        default: break;
      }
    }
    { const bool last_exec = (st + 1 >= step_hi) && ((st2 & 1) || !((REPEAT_MASK >> st) & 1));
      if (sync_after && !last_exec) { if (step_lo > 1000) cg::this_grid().sync(); else xcd_barrier(xb); } }
  }
}

extern "C" void kernel_launch(void* const* d_in, const int* in_sizes, int n_in, void* d_out, int out_size, void* d_ws, size_t ws_size, hipStream_t stream) {
  static int grid_blocks = 0;
  if (!grid_blocks) {
    hipFuncSetAttribute((const void*)fwd_kernel, hipFuncAttributeMaxDynamicSharedMemorySize, LDS_BYTES + 16);
    int dev = 0, cus = 0, per_cu = 0;
    hipGetDevice(&dev);
    hipDeviceGetAttribute(&cus, hipDeviceAttributeMultiprocessorCount, dev);
    hipOccupancyMaxActiveBlocksPerMultiprocessor(&per_cu, fwd_kernel, 512, LDS_BYTES);
    if (per_cu < 1) per_cu = 1;
    grid_blocks = cus;
  }
  Params p;
  memset(&p, 0, sizeof(p));
  p.x = (const float*)d_in[0]; p.pos = (const int*)d_in[1]; p.norm_mix = (const float*)d_in[2]; p.norm_mlp = (const float*)d_in[3]; p.norm_final = (const float*)d_in[4];
  p.w_in = (const float*)d_in[5]; p.lq1 = (const float*)d_in[6]; p.lk1 = (const float*)d_in[7]; p.lq2 = (const float*)d_in[8]; p.lk2 = (const float*)d_in[9]; p.subln = (const float*)d_in[10];
  p.q_norm = (const float*)d_in[11]; p.kv_norm = (const float*)d_in[12]; p.w_uq = (const float*)d_in[13]; p.w_ukv = (const float*)d_in[14]; p.w_out = (const float*)d_in[15];
  p.rw_in = (const float*)d_in[16]; p.conv_w = (const float*)d_in[17]; p.conv_b = (const float*)d_in[18]; p.w_a = (const float*)d_in[19]; p.b_a = (const float*)d_in[20]; p.w_x = (const float*)d_in[21]; p.b_x = (const float*)d_in[22];
  p.rlam = (const float*)d_in[23]; p.rw_out = (const float*)d_in[24]; p.w1 = (const float*)d_in[25]; p.w2 = (const float*)d_in[26];
  p.out = (float*)d_out;
  bf16_t* w = (bf16_t*)d_ws;
  p.Wt_in = w;  w += (size_t)4416 * 2048;
  p.Wt_uq = w;  w += (size_t)1536 * 768;
  p.Wt_ukv = w; w += (size_t)2048 * 512;
  p.Wt_out = w; w += (size_t)2048 * 2048;
  p.Wt_rin = w; w += (size_t)4096 * 2048;
  p.Wt_gate = w; w += (size_t)4096 * 256;
  p.Wt_rout = w; w += (size_t)2048 * 2048;
  p.Wt_w1 = w;  w += (size_t)2 * 8192 * 2048;
  p.Wt_w2 = w;  w += (size_t)2 * 8192 * 2048;
  p.act = w;    w += (size_t)T_TOK * DM;
  p.X = w;      w += (size_t)T_TOK * 8192;
  p.cs = (float*)w; w += (size_t)T_TOK * 32 * 2 * 2;
  p.sp8 = (float*)w; w += (size_t)DM * 2;
  p.bar = (unsigned*)w; w += (size_t)XCD_BAR_WORDS * 2;
  p.ssq = (u64_t*)w; w += (size_t)5 * T_TOK * 4;
  for (int i = 0; i < 32; ++i) p.inv_freq[i] = 1.0f / powf(10000.0f, (float)(2 * i) / 64.0f);
  {
    bf16_t* const X = p.X;
    bf16_t* const qkva = X; bf16_t* const lat = X + (size_t)T_TOK * 3072; bf16_t* const qbuf = lat + (size_t)T_TOK * 1536; bf16_t* const kvbuf = qbuf + (size_t)T_TOK * 1536;
    bf16_t* const ybuf = X; bf16_t* const xr = X + (size_t)T_TOK * DM; bf16_t* const labuf = xr + (size_t)T_TOK * DM; bf16_t* const bbuf = labuf + (size_t)T_TOK * DM;
    for (int i = 0; i < 24; ++i) p.step_gd[i] = -1;
    int n = 0;
    auto add = [&](int step, const bf16_t* A, const bf16_t* Bt, int M, int N, int K, int lda, int ldb, int gate, int kind, void* p0, void* p1, const void* q0, const void* q1, const void* q2, const void* q3, int ld0, int ld1, int split, int mode, float inv_n) {
      GD& d = p.gd[n]; d.A = A; d.Bt = Bt; d.p0 = p0; d.p1 = p1; d.q0 = q0; d.q1 = q1; d.q2 = q2; d.q3 = q3; d.M = M; d.N = N; d.K = K; d.lda = lda; d.ldb = ldb; d.gate = gate; d.kind = kind; d.ld0 = ld0; d.ld1 = ld1; d.split = split; d.mode = mode;
      { const float sc = inv_n / 1048576.f; memcpy(&d.pad, &sc, 4); }
      p.step_gd[step] = n++; };
    bf16_t* const HB = X + (size_t)T_TOK * 6144;
    bf16_t* const U = p.act;
    u64_t* const sq0 = p.ssq; u64_t* const sq1 = p.ssq + T_TOK; u64_t* const sq2 = p.ssq + 2 * T_TOK; u64_t* const sqq = p.ssq + 3 * T_TOK; u64_t* const sqkv = p.ssq + 4 * T_TOK;
    add(1, p.act, p.Wt_in, T_TOK, 4608, 2048, 2048, 2048, 0, 1, qkva, lat, p.cs, nullptr, sqq, sqkv, 3072, 1536, 12, 4, 0.f);
    p.step_gd[2] = -2;
    add(3, lat, p.Wt_uq, T_TOK, 1536, 768, 1536, 768, 0, 1, qbuf, qbuf, p.cs, sqq, nullptr, nullptr, 1536, 1536, 1000, 3, 1.f / 768.f);
    add(4, lat + 768, p.Wt_ukv, T_TOK, 2048, 512, 1536, 512, 0, 1, kvbuf, kvbuf, nullptr, sqkv, nullptr, nullptr, 2048, 2048, 1000, 0, 1.f / 512.f);
    add(6, p.act, p.Wt_out, T_TOK, 2048, 2048, 2048, 2048, 0, 2, nullptr, HB, p.x, sq0, nullptr, nullptr, 0, 0, 0, 0, 0.f);
    p.step_gd[7] = -2;
    add(8, HB, p.Wt_w1, T_TOK, 8192, 2048, 2048, 2048, 0, 1, U, U, nullptr, sq0, nullptr, nullptr, 8192, 8192, 1000, 1, 1.f / 2048.f);
    add(9, U, p.Wt_w2, T_TOK, 2048, 8192, 8192, 8192, 0, 2, nullptr, HB, nullptr, sq1, HB, nullptr, 0, 0, 0, 0, 0.f);
    p.step_gd[10] = -2;
    add(11, HB, p.Wt_rin, T_TOK, 4096, 2048, 2048, 2048, 0, 1, ybuf, xr, nullptr, sq1, nullptr, nullptr, 2048, 2048, 8, 2, 1.f / 2048.f);
    add(13, p.act, p.Wt_gate, T_TOK, 4096, 256, 2048, 256, 1, 3, labuf, (bf16_t*)p.out, p.act, p.b_a, p.b_x, p.sp8, 0, 0, 0, 0, 0.f);
    add(17, p.act, p.Wt_rout, T_TOK, 2048, 2048, 2048, 2048, 0, 2, nullptr, HB, nullptr, sq2, HB, nullptr, 0, 0, 0, 0, 0.f);
    p.step_gd[18] = -2;
    add(19, HB, p.Wt_w1 + (size_t)8192 * 2048, T_TOK, 8192, 2048, 2048, 2048, 0, 1, U, U, nullptr, sq2, nullptr, nullptr, 8192, 8192, 1000, 1, 1.f / 2048.f);
    add(20, U, p.Wt_w2 + (size_t)8192 * 2048, T_TOK, 2048, 8192, 8192, 8192, 0, 2, p.out, nullptr, nullptr, nullptr, HB, nullptr, 0, 0, 0, 0, 0.f);
  }
#if N_LAUNCH_MODE == 1
  p.step_lo = 0; p.step_hi = NSTEP;
  hipMemsetAsync(p.bar, 0, XCD_BAR_WORDS * 4, stream);
  void* args[] = {&p};
  hipError_t e = hipLaunchCooperativeKernel((const void*)fwd_kernel, dim3(grid_blocks), dim3(512), args, LDS_BYTES + 16, stream);
  if (e != hipSuccess) fprintf(stderr, "cooperative launch failed: %s (grid %d)\n", hipGetErrorString(e), grid_blocks);
#else
  for (int st = 0; st < NSTEP; ++st) {
    p.step_lo = st; p.step_hi = st + 1;
    hipLaunchKernelGGL(fwd_kernel, dim3(grid_blocks), dim3(512), LDS_BYTES + 16, stream, p);
  }
#endif
}
#ifdef TESTK
__global__ void __launch_bounds__(512, 2) tk1(Gemm g, EpiBf e) { extern __shared__ __attribute__((aligned(16))) unsigned char shm[]; StaticOrder S; S.init(g.M, g.N, (int)gridDim.x, (int)blockIdx.x); pg8::gemm_phase<EpiBf>((LAS unsigned char*)shm, g, S, e); }
__global__ void __launch_bounds__(512, 2) tk2(Gemm g, EpiRes e) { extern __shared__ __attribute__((aligned(16))) unsigned char shm[]; StaticOrder S; S.init(g.M, g.N, (int)gridDim.x, (int)blockIdx.x); pg8::gemm_phase<EpiRes>((LAS unsigned char*)shm, g, S, e); }
__global__ void __launch_bounds__(512, 2) tk3(Gemm g, EpiGate e) { extern __shared__ __attribute__((aligned(16))) unsigned char shm[]; StaticOrder S; S.init(g.M, g.N, (int)gridDim.x, (int)blockIdx.x); pg8::gemm_phase<EpiGate>((LAS unsigned char*)shm, g, S, e); }
#endif
```

```cpp
#include <hip/hip_runtime.h>
#include <hip/hip_cooperative_groups.h>
#include <cstdio>
#include <cmath>
#include <cstring>
namespace cg = cooperative_groups;

#ifndef N_LAUNCH_MODE
#define N_LAUNCH_MODE 1
#endif

#ifdef ONLY
#ifdef ONLY2
#define EN(n) ((n)==ONLY || (n)==ONLY2 || (n)==ONLY3)
#else
#define EN(n) ((n)==ONLY)
#endif
#else
#define EN(n) true
#endif
#define LAS __attribute__((address_space(3)))
#define DI __device__ __forceinline__
typedef unsigned short bf16_t;
typedef short bf16x8 __attribute__((ext_vector_type(8)));
typedef short s16x4 __attribute__((ext_vector_type(4)));
typedef float f32x2 __attribute__((ext_vector_type(2)));
typedef float f32x4 __attribute__((ext_vector_type(4)));
typedef float f32x16 __attribute__((ext_vector_type(16)));
typedef unsigned u32x2 __attribute__((ext_vector_type(2)));
typedef unsigned u32x4 __attribute__((ext_vector_type(4)));
typedef unsigned long long u64_t;


constexpr int T_TOK = 16384, SEQ = 4096, DM = 2048, NB = 4;
constexpr int LDS_BYTES = 131072;

struct GD { const bf16_t* A; const bf16_t* Bt; void* p0; void* p1; const void* q0; const void* q1; const void* q2; const void* q3; int M, N, K, lda, ldb, gate, kind, ld0, ld1, split, mode, pad; };
struct Params {
  const float* x; const int* pos; const float* norm_mix; const float* norm_mlp; const float* norm_final;
  const float* w_in; const float* lq1; const float* lk1; const float* lq2; const float* lk2; const float* subln;
  const float* q_norm; const float* kv_norm; const float* w_uq; const float* w_ukv; const float* w_out;
  const float* rw_in; const float* conv_w; const float* conv_b; const float* w_a; const float* b_a; const float* w_x; const float* b_x;
  const float* rlam; const float* rw_out; const float* w1; const float* w2;
  float* out;
  bf16_t *Wt_in, *Wt_uq, *Wt_ukv, *Wt_out, *Wt_rin, *Wt_gate, *Wt_rout, *Wt_w1, *Wt_w2;
  bf16_t* act; bf16_t* X; float* cs; float* sp8; unsigned* bar; u64_t* ssq;
  float inv_freq[32];
  int step_lo, step_hi;
  GD gd[11];
  int step_gd[24];
};
typedef const __attribute__((address_space(4))) Params* KParams;

DI unsigned cvt_pk_bf16(float lo, float hi) { unsigned r; asm volatile("v_cvt_pk_bf16_f32 %0, %1, %2" : "=v"(r) : "v"(lo), "v"(hi)); return r; }
DI float bf_lo(unsigned w) { return __uint_as_float(w << 16); }
DI float bf_hi(unsigned w) { return __uint_as_float(w & 0xffff0000u); }
DI float bf2f(bf16_t b) { return __uint_as_float(((unsigned)b) << 16); }
DI float wave_sum(float v) {
#pragma unroll
  for (int o = 32; o >= 1; o >>= 1) v += __shfl_xor(v, o);
  return v;
}

DI int tid_fresh() { int t = threadIdx.x; asm volatile("" : "+v"(t)); return t; }
namespace pg8 {
constexpr int BM = 256, BK = 64, HALF = 128, HTB = HALF * BK * 2, NXCD = 8, WGM = 8;
DI int lds_byte(int r, int c) { const int st = (r >> 4) * 2 + (c >> 5), rr = r & 15, cc = c & 31, ob = rr * 64 + cc * 2; return st * 1024 + (ob ^ (((ob >> 9) & 1) << 5)); }
DI void stage_rc(int b, int& R, int& C) { const int st = b / 1024, sb = b % 1024, swz = sb ^ (((sb >> 9) & 1) << 5); R = (st >> 1) * 16 + swz / 64; C = (st & 1) * 32 + (swz % 64) / 2; }
DI int perm32(int rho) { const int n = rho >> 4, i = rho & 15; return 8 * (i >> 2) + 4 * n + (i & 3); }

struct Unit { int pm, pn; };
struct Gemm { const bf16_t* A; const bf16_t* Bt; int M, N, K, lda, ldb, gate; };

struct StaticOrder {
  int nM, nN, nwg, G, c;
  DI void init(int M, int N, int G_, int c_) { nM = M / BM; nN = N / BM; nwg = nM * nN; G = G_; c = c_; }
  DI bool next(int i, Unit& u) const {
    const long L = (long)i * G + c; if (L >= nwg) return false;
    int wgid = (int)L; { const int q = nwg / NXCD, r = nwg % NXCD, xcd = wgid % NXCD, off = wgid / NXCD; wgid = (xcd < r ? xcd * (q + 1) : r * (q + 1) + (xcd - r) * q) + off; }
    const int nig = WGM * nN, gid = wgid / nig, fm = gid * WGM, gsz = (nM - fm) < WGM ? (nM - fm) : WGM;
    u.pm = fm + ((wgid % nig) % gsz); u.pn = (wgid % nig) / gsz; return true;
  }
};

template <class Epi>
DI void gemm_phase(LAS unsigned char* lds, const Gemm g, const StaticOrder& S, const Epi& E) {
  const int tid = tid_fresh(), wid = __builtin_amdgcn_readfirstlane(tid >> 6), lane = tid & 63, wr = wid >> 2, wc = wid & 3, fr = lane & 15, fq = lane >> 4;
  const int K = g.K, nt = K / BK;
  unsigned voffA[2], voffB[2];
#pragma unroll
  for (int i = 0; i < 2; ++i) { int R, C; stage_rc(tid * 16 + i * 8192, R, C); const int Rb = Epi::PERM ? ((R & ~31) + perm32(R & 31)) : R;
    voffA[i] = (unsigned)(R * g.lda + C) * 2u; voffB[i] = (unsigned)(Rb * g.ldb + C) * 2u; }
  const size_t kstep = (size_t)(BK * 2);
  const size_t hstepA = (size_t)HALF * g.lda * 2, hstepB = (size_t)HALF * g.ldb * 2;
  const unsigned ldsw = (unsigned)wid * 1024u;
  const int aoff = lds_byte(wr * 64 + fr, fq * 8), boff = lds_byte(wc * 32 + fr, fq * 8);
#define PG8_UA(u) ((const char*)g.A + ((size_t)(u).pm * 256 * g.lda + (g.gate ? (size_t)((u).pn >> 1) * 256 : 0)) * 2)
#define PG8_UB(u) ((const char*)g.Bt + ((size_t)(u).pn * 256 * g.ldb) * 2)
#define PG8_SA(b, h) (((b) * 2 + (h)) * HTB)
#define PG8_SB(b, h) ((4 + (b) * 2 + (h)) * HTB)
#define PG8_STAGE(bufoff, gbase, voff) do { _Pragma("unroll") for (int _i = 0; _i < 2; ++_i) \
    __builtin_amdgcn_global_load_lds((const unsigned*)((const char*)(gbase) + (voff)[_i]), (LAS unsigned*)(lds + (bufoff) + ldsw + _i * 8192), 16, 0, 0); } while (0)
#define PG8_LDA(dst, b, h) do { _Pragma("unroll") for (int m = 0; m < 4; ++m) _Pragma("unroll") for (int k = 0; k < 2; ++k) dst[m][k] = *(const LAS bf16x8*)(lds + PG8_SA(b, h) + aoff + m * 2048 + k * 1024); } while (0)
#define PG8_LDB(dst, b, h) do { _Pragma("unroll") for (int n = 0; n < 2; ++n) _Pragma("unroll") for (int k = 0; k < 2; ++k) dst[n][k] = *(const LAS bf16x8*)(lds + PG8_SB(b, h) + boff + n * 2048 + k * 1024); } while (0)
#define PG8_MMA(ai, bj, At, Bt) do { __builtin_amdgcn_s_setprio(1); _Pragma("unroll") for (int m = 0; m < 4; ++m) _Pragma("unroll") for (int n = 0; n < 2; ++n) _Pragma("unroll") for (int k = 0; k < 2; ++k) \
    acc[ai][bj][m][n] = __builtin_amdgcn_mfma_f32_16x16x32_bf16(Bt[n][k], At[m][k], acc[ai][bj][m][n], 0, 0, 0); __builtin_amdgcn_s_setprio(0); } while (0)
#define PG8_WAIT_V(n) asm volatile("s_waitcnt vmcnt(" #n ")" ::: "memory")
#define PG8_WAIT_L(n) asm volatile("s_waitcnt lgkmcnt(" #n ")" ::: "memory")
#define PG8_BAR __builtin_amdgcn_s_barrier()
#define PG8_SCHED __builtin_amdgcn_sched_barrier(0)
  Unit cur, nxt; int ui = 0;
  if (!S.next(0, cur)) return;
  f32x4 acc[2][2][4][2];
#pragma unroll
  for (int a = 0; a < 2; ++a)
#pragma unroll
    for (int b = 0; b < 2; ++b)
#pragma unroll
      for (int m = 0; m < 4; ++m)
#pragma unroll
        for (int n = 0; n < 2; ++n) acc[a][b][m][n] = (f32x4){0.f, 0.f, 0.f, 0.f};
  bf16x8 At[4][2], B0[2][2], B1[2][2];
  const char* cA = PG8_UA(cur); const char* cB = PG8_UB(cur);
  PG8_STAGE(PG8_SB(0, 0), cB, voffB); PG8_STAGE(PG8_SB(0, 1), cB + hstepB, voffB); PG8_STAGE(PG8_SA(0, 0), cA, voffA); PG8_STAGE(PG8_SA(0, 1), cA + hstepA, voffA);
  if (wr == 1) PG8_BAR;
  PG8_WAIT_V(2); PG8_BAR;
  PG8_STAGE(PG8_SB(1, 0), cB + kstep, voffB); PG8_STAGE(PG8_SA(1, 0), cA + kstep, voffA); PG8_STAGE(PG8_SB(1, 1), cB + hstepB + kstep, voffB);
  PG8_WAIT_V(6); PG8_BAR;
  for (;;) {
    const bool has_next = S.next(ui + 1, nxt);
    const char* nA = has_next ? PG8_UA(nxt) : cA; const char* nB = has_next ? PG8_UB(nxt) : cB;
    for (int t = 0; t < nt; t += 2) {
      const bool last = (t == nt - 2);
      const char* a1 = cA + (size_t)(t + 1) * kstep;
      const char* a2 = last ? nA : cA + (size_t)(t + 2) * kstep; const char* b2 = last ? nB : cB + (size_t)(t + 2) * kstep;
      const char* a3 = a2 + kstep; const char* b3 = b2 + kstep;
      PG8_LDB(B0, 0, 0); PG8_LDB(B1, 0, 1); PG8_SCHED; PG8_LDA(At, 0, 0); PG8_STAGE(PG8_SA(1, 1), a1 + hstepA, voffA);
      PG8_WAIT_V(8); PG8_WAIT_L(0); PG8_BAR; PG8_MMA(0, 0, At, B0); PG8_MMA(0, 1, At, B1); PG8_BAR; PG8_SCHED;
      PG8_LDA(At, 0, 1); PG8_STAGE(PG8_SB(0, 0), b2, voffB); PG8_STAGE(PG8_SB(0, 1), b2 + hstepB, voffB); PG8_STAGE(PG8_SA(0, 0), a2, voffA);
      PG8_WAIT_V(8); PG8_WAIT_L(0); PG8_BAR; PG8_MMA(1, 0, At, B0); PG8_MMA(1, 1, At, B1); PG8_BAR; PG8_SCHED;
      PG8_LDB(B0, 1, 0); PG8_LDB(B1, 1, 1); PG8_SCHED; PG8_LDA(At, 1, 0); PG8_STAGE(PG8_SA(0, 1), a2 + hstepA, voffA);
      PG8_WAIT_V(8); PG8_WAIT_L(0); PG8_BAR; PG8_MMA(0, 0, At, B0); PG8_MMA(0, 1, At, B1); PG8_BAR; PG8_SCHED;
      PG8_LDA(At, 1, 1); PG8_STAGE(PG8_SB(1, 0), b3, voffB); PG8_STAGE(PG8_SB(1, 1), b3 + hstepB, voffB); PG8_STAGE(PG8_SA(1, 0), a3, voffA);
      PG8_WAIT_V(8); PG8_WAIT_L(0); PG8_BAR; PG8_MMA(1, 0, At, B0); PG8_MMA(1, 1, At, B1); PG8_BAR; PG8_SCHED;
    }
    if (wr == 0) PG8_BAR;
    E(acc, cur, wr, wc, fr, fq);
    if (!has_next) break;
#pragma unroll
    for (int a = 0; a < 2; ++a)
#pragma unroll
      for (int b = 0; b < 2; ++b)
#pragma unroll
        for (int m = 0; m < 4; ++m)
#pragma unroll
          for (int n = 0; n < 2; ++n) acc[a][b][m][n] = (f32x4){0.f, 0.f, 0.f, 0.f};
    cur = nxt; cA = nA; cB = nB; ++ui;
    if (wr == 1) PG8_BAR;
  }
  PG8_WAIT_V(0);
  PG8_BAR;
#undef PG8_UA
#undef PG8_UB
#undef PG8_SA
#undef PG8_SB
#undef PG8_STAGE
#undef PG8_LDA
#undef PG8_LDB
#undef PG8_MMA
#undef PG8_WAIT_V
#undef PG8_WAIT_L
#undef PG8_BAR
#undef PG8_SCHED
}
}
using pg8::Unit; using pg8::Gemm; using pg8::StaticOrder;

struct EpiBf {
  static constexpr bool PERM = true;
  bf16_t* o0; int ld0; bf16_t* o1; int ld1; int split; int mode; const float* cs;
  const u64_t* ssq; float inv_n;
  u64_t* sqa; u64_t* sqb;
  DI void operator()(const f32x4 (&acc)[2][2][4][2], const Unit& u, int wr, int wc, int fr, int fq) const {
    const int row0 = u.pm * 256 + wr * 64 + fr;
    bf16_t* base; int ld, colt;
    if (u.pn < split) { base = o0; ld = ld0; colt = u.pn * 256; } else { base = o1; ld = ld1; colt = (u.pn - split) * 256; }
    const bool gelu = (mode == 2) && (u.pn < split);
    u64_t* sq = nullptr;
    if (mode == 4) { if (u.pn >= 12 && u.pn < 15) sq = sqa; else if (u.pn >= 15 && u.pn < 17) sq = sqb; }
    const bool krope = (mode == 4) && (u.pn == 17) && (wc < 2);
    float rsv[8];
#pragma unroll
    for (int i = 0; i < 8; ++i) rsv[i] = 1.f;
    if (ssq) {
#pragma unroll
      for (int i = 0; i < 8; ++i) rsv[i] = (float)ssq[row0 + (i >> 2) * 128 + (i & 3) * 16];
#pragma unroll
      for (int i = 0; i < 8; ++i) rsv[i] = rsqrtf(rsv[i] * inv_n + 1e-6f);
    }
#pragma unroll
    for (int ai = 0; ai < 2; ++ai)
#pragma unroll
      for (int m = 0; m < 4; ++m) {
        const int row = row0 + ai * 128 + m * 16;
        bf16_t* rowp = base + (size_t)row * ld + colt + wc * 32 + 8 * fq;
        const float rs = rsv[ai * 4 + m];
        if (sq) {
          float ss = 0.f;
#pragma unroll
          for (int bj = 0; bj < 2; ++bj)
#pragma unroll
            for (int n = 0; n < 2; ++n) { const f32x4 x = acc[ai][bj][m][n]; ss += x[0] * x[0] + x[1] * x[1] + x[2] * x[2] + x[3] * x[3]; }
          ss += __shfl_xor(ss, 16); ss += __shfl_xor(ss, 32);
          if (fq == 0) atomicAdd(sq + row, (u64_t)(ss * 1048576.f));
        }
#pragma unroll
        for (int bj = 0; bj < 2; ++bj) {
          f32x4 v0 = acc[ai][bj][m][0] * rs, v1 = acc[ai][bj][m][1] * rs;
          if (krope && bj == 0) {
            const float* c = cs + ((size_t)row * 32 + (wc * 32 + 8 * fq) / 2) * 2;
            const f32x4 cA = *(const f32x4*)c, cB = *(const f32x4*)(c + 4);
            f32x4 w0, w1;
            w0[0] = v0[0] * cA[0] - v0[1] * cA[1]; w0[1] = v0[1] * cA[0] + v0[0] * cA[1];
            w0[2] = v0[2] * cA[2] - v0[3] * cA[3]; w0[3] = v0[3] * cA[2] + v0[2] * cA[3];
            w1[0] = v1[0] * cB[0] - v1[1] * cB[1]; w1[1] = v1[1] * cB[0] + v1[0] * cB[1];
            w1[2] = v1[2] * cB[2] - v1[3] * cB[3]; w1[3] = v1[3] * cB[2] + v1[2] * cB[3];
            v0 = w0; v1 = w1;
          }
          if (mode == 1) {
#pragma unroll
            for (int j = 0; j < 4; ++j) { const float a = fmaxf(v0[j], 0.f), b = fmaxf(v1[j], 0.f); v0[j] = a * a; v1[j] = b * b; }
          }
          if (gelu) {
#pragma unroll
            for (int j = 0; j < 4; ++j) {
              { const float xx = v0[j]; const float z = 1.5957691216f * (xx + 0.044715f * xx * xx * xx); v0[j] = xx * __builtin_amdgcn_rcpf(1.f + __expf(-z)); }
              { const float xx = v1[j]; const float z = 1.5957691216f * (xx + 0.044715f * xx * xx * xx); v1[j] = xx * __builtin_amdgcn_rcpf(1.f + __expf(-z)); }
            }
          }
          if (mode == 3) {
            const int gc = u.pn * 256 + bj * 128 + wc * 32 + 8 * fq; const int ch = gc % 192;
            if (ch >= 128) {
              const float* c = cs + ((size_t)row * 32 + ((ch - 128) >> 1)) * 2;
              const f32x4 cA = *(const f32x4*)c, cB = *(const f32x4*)(c + 4);
              f32x4 w0, w1;
              w0[0] = v0[0] * cA[0] - v0[1] * cA[1]; w0[1] = v0[1] * cA[0] + v0[0] * cA[1];
              w0[2] = v0[2] * cA[2] - v0[3] * cA[3]; w0[3] = v0[3] * cA[2] + v0[2] * cA[3];
              w1[0] = v1[0] * cB[0] - v1[1] * cB[1]; w1[1] = v1[1] * cB[0] + v1[0] * cB[1];
              w1[2] = v1[2] * cB[2] - v1[3] * cB[3]; w1[3] = v1[3] * cB[2] + v1[2] * cB[3];
              v0 = w0; v1 = w1;
            }
          }
          u32x4 w; w.x = cvt_pk_bf16(v0[0], v0[1]); w.y = cvt_pk_bf16(v0[2], v0[3]); w.z = cvt_pk_bf16(v1[0], v1[1]); w.w = cvt_pk_bf16(v1[2], v1[3]);
          *(u32x4*)(rowp + bj * 128) = w;
        }
      }
  }
};
struct EpiRes {
  static constexpr bool PERM = false;
  const float* basef; const bf16_t* baseh; float* out; bf16_t* hb; u64_t* ssq;
  DI void operator()(const f32x4 (&acc)[2][2][4][2], const Unit& u, int wr, int wc, int fr, int fq) const {
    const int row0 = u.pm * 256 + wr * 64 + fr, col0 = u.pn * 256 + wc * 32 + 4 * fq;
    f32x4 cur[4], nxt[4];
    auto loadrow = [&](int row, f32x4 (&d)[4]) {
      const size_t off = (size_t)row * DM + col0;
      if (basef) {
#pragma unroll
        for (int q = 0; q < 4; ++q) d[q] = *(const f32x4*)(basef + off + (q >> 1) * 128 + (q & 1) * 16);
      } else {
#pragma unroll
        for (int q = 0; q < 4; ++q) { const u32x2 w = *(const u32x2*)(baseh + off + (q >> 1) * 128 + (q & 1) * 16); d[q] = (f32x4){bf_lo(w.x), bf_hi(w.x), bf_lo(w.y), bf_hi(w.y)}; }
      }
    };
    loadrow(row0, cur);
#pragma unroll
    for (int idx = 0; idx < 8; ++idx) {
      const int ai = idx >> 2, m = idx & 3;
      const int row = row0 + ai * 128 + m * 16;
      const size_t off = (size_t)row * DM + col0;
      if (idx + 1 < 8) loadrow(row0 + ((idx + 1) >> 2) * 128 + ((idx + 1) & 3) * 16, nxt);
      float ss = 0.f;
#pragma unroll
      for (int q = 0; q < 4; ++q) {
        const int bj = q >> 1, n = q & 1;
        const f32x4 o = cur[q] + acc[ai][bj][m][n];
        if (out) *(f32x4*)(out + off + bj * 128 + n * 16) = o;
        if (hb) { u32x2 w; w.x = cvt_pk_bf16(o[0], o[1]); w.y = cvt_pk_bf16(o[2], o[3]); *(u32x2*)(hb + off + bj * 128 + n * 16) = w; }
        if (ssq) ss += o[0] * o[0] + o[1] * o[1] + o[2] * o[2] + o[3] * o[3];
      }
      if (ssq) { ss += __shfl_xor(ss, 16); ss += __shfl_xor(ss, 32); if (fq == 0) atomicAdd(ssq + row, (u64_t)(ss * 1048576.f)); }
#pragma unroll
      for (int q = 0; q < 4; ++q) cur[q] = nxt[q];
    }
  }
};
struct EpiGate {
  static constexpr bool PERM = true;
  const bf16_t* xc; const float* ba; const float* bx; const float* sp8; bf16_t* la; bf16_t* bo;
  DI void operator()(const f32x4 (&acc)[2][2][4][2], const Unit& u, int wr, int wc, int fr, int fq) const {
    const int row0 = u.pm * 256 + wr * 64 + fr;
    const int ch0 = (u.pn >> 1) * 256 + (u.pn & 1) * 128 + wc * 32 + 8 * fq;
    float bav[8], bxv[8], spv[8];
    { const f32x4 a0 = *(const f32x4*)(ba + ch0), a1 = *(const f32x4*)(ba + ch0 + 4), x0 = *(const f32x4*)(bx + ch0), x1 = *(const f32x4*)(bx + ch0 + 4), s0 = *(const f32x4*)(sp8 + ch0), s1 = *(const f32x4*)(sp8 + ch0 + 4);
#pragma unroll
      for (int j = 0; j < 4; ++j) { bav[j] = a0[j]; bav[4 + j] = a1[j]; bxv[j] = x0[j]; bxv[4 + j] = x1[j]; spv[j] = s0[j]; spv[4 + j] = s1[j]; } }
    u32x4 xw = *(const u32x4*)(xc + (size_t)row0 * DM + ch0), xwn = xw;
#pragma unroll
    for (int idx = 0; idx < 8; ++idx) {
        const int ai = idx >> 2, m = idx & 3;
        const size_t off = (size_t)(row0 + ai * 128 + m * 16) * DM + ch0;
        if (idx + 1 < 8) xwn = *(const u32x4*)(xc + (size_t)(row0 + ((idx + 1) >> 2) * 128 + ((idx + 1) & 3) * 16) * DM + ch0);
        float xv[8]; xv[0] = bf_lo(xw.x); xv[1] = bf_hi(xw.x); xv[2] = bf_lo(xw.y); xv[3] = bf_hi(xw.y); xv[4] = bf_lo(xw.z); xv[5] = bf_hi(xw.z); xv[6] = bf_lo(xw.w); xv[7] = bf_hi(xw.w);
        float lav[8], bv[8];
#pragma unroll
        for (int n = 0; n < 2; ++n)
#pragma unroll
          for (int j = 0; j < 4; ++j) {
            const int e = 4 * n + j;
            const float r = __builtin_amdgcn_rcpf(1.f + __expf(-(acc[ai][0][m][n][j] + bav[e])));
            const float ig = __builtin_amdgcn_rcpf(1.f + __expf(-(acc[ai][1][m][n][j] + bxv[e])));
            const float l = -r * spv[e];
            const float x2 = 2.f * l;
            const float om = (x2 > -0.1f) ? -x2 * (1.f + x2 * (0.5f + x2 * (0.16666667f + x2 * 0.041666668f))) : 1.f - __expf(x2);
            lav[e] = l; bv[e] = sqrtf(om) * ig * xv[e];
          }
        u32x4 wl, wb;
        wl.x = cvt_pk_bf16(lav[0], lav[1]); wl.y = cvt_pk_bf16(lav[2], lav[3]); wl.z = cvt_pk_bf16(lav[4], lav[5]); wl.w = cvt_pk_bf16(lav[6], lav[7]);
        wb.x = cvt_pk_bf16(bv[0], bv[1]); wb.y = cvt_pk_bf16(bv[2], bv[3]); wb.z = cvt_pk_bf16(bv[4], bv[5]); wb.w = cvt_pk_bf16(bv[6], bv[7]);
        *(u32x4*)(la + off) = wl; *(u32x4*)(bo + off) = wb;
        xw = xwn;
      }
  }
};

struct CvtJob { const float* src; int ld_src; bf16_t* dst; int ld_dst; int perm; const float* gain; };
DI CvtJob cvt_decode(KParams P, int tile) {
  constexpr int NJ = 11;
  const int jK[NJ]  = {2048, 768, 512, 2048, 2048, 256, 2048, 2048, 8192, 2048, 8192};
  const int jNT[NJ] = {69, 24, 32, 32, 64, 64, 32, 128, 32, 128, 32};
  int j = 0, idx = tile;
#pragma unroll
  for (int jj = 0; jj < NJ - 1; ++jj) { const int cnt = (jK[jj] / 128) * jNT[jj]; if (j == jj && idx >= cnt) { idx -= cnt; j = jj + 1; } }
  int K = 2048;
  switch (j) { case 1: K = 768; break; case 2: K = 512; break; case 5: K = 256; break; case 8: case 10: K = 8192; break; default: break; }
  const int nkt = K / 128, kt = idx % nkt, ntile = idx / nkt, k0 = kt * 128, n0 = ntile * 64;
  const float* src; int ld_src; bf16_t* dst; int perm = 0; const float* gain = nullptr;
  switch (j) {
    case 0: src = P->w_in + (size_t)k0 * 4416 + n0; ld_src = 4416; dst = P->Wt_in; perm = (ntile == 68) ? 1 : 0; break;
    case 1: src = P->w_uq + (size_t)k0 * 1536 + n0; ld_src = 1536; dst = P->Wt_uq; perm = ((ntile % 3) == 2) ? 1 : 0; gain = P->q_norm + k0; break;
    case 2: src = P->w_ukv + (size_t)k0 * 2048 + n0; ld_src = 2048; dst = P->Wt_ukv; gain = P->kv_norm + k0; break;
    case 3: src = P->w_out + (size_t)k0 * 2048 + n0; ld_src = 2048; dst = P->Wt_out; break;
    case 4: src = P->rw_in + (size_t)k0 * 4096 + n0; ld_src = 4096; dst = P->Wt_rin; gain = P->norm_mix + DM + k0; break;
    case 5: { const int pn = n0 >> 8, rr = n0 & 255, blk = pn >> 1, half = pn & 1;
              src = (rr < 128 ? P->w_a : P->w_x) + (size_t)blk * 65536 + (size_t)k0 * 256 + half * 128 + (rr & 127); ld_src = 256; dst = P->Wt_gate; } break;
    case 6: src = P->rw_out + (size_t)k0 * 2048 + n0; ld_src = 2048; dst = P->Wt_rout; break;
    case 7: src = P->w1 + (size_t)2048 * 8192 + (size_t)k0 * 8192 + n0; ld_src = 8192; dst = P->Wt_w1 + (size_t)8192 * 2048; gain = P->norm_mlp + DM + k0; break;
    case 8: src = P->w2 + (size_t)8192 * 2048 + (size_t)k0 * 2048 + n0; ld_src = 2048; dst = P->Wt_w2 + (size_t)2048 * 8192; break;
    case 9: src = P->w1 + (size_t)k0 * 8192 + n0; ld_src = 8192; dst = P->Wt_w1; gain = P->norm_mlp + k0; break;
    default: src = P->w2 + (size_t)k0 * 2048 + n0; ld_src = 2048; dst = P->Wt_w2; break;
  }
  CvtJob jb; jb.src = src; jb.ld_src = ld_src; jb.dst = dst + (size_t)n0 * K + k0; jb.ld_dst = K; jb.perm = perm; jb.gain = gain; return jb;
}
constexpr int CVT_TOTAL = 16 * 69 + 6 * 24 + 4 * 32 + 16 * 32 + 16 * 64 + 2 * 64 + 16 * 32 + 16 * 128 + 16 * 128 + 64 * 32 + 64 * 32;
constexpr int CVT_DEFER = 3072;
DI void convert_tiles(KParams P, LAS unsigned char* lds, int first, int stride, int total) {
  const int tid = tid_fresh(), kr = tid >> 4, c4 = tid & 15;
  f32x4 cur[4], nxt[4];
  int tile = first;
  CvtJob jb;
  if (tile < total) { jb = cvt_decode(P, tile);
#pragma unroll
    for (int p = 0; p < 2; ++p) { const int k = 64 * p + 2 * kr; cur[2 * p] = __builtin_nontemporal_load((const f32x4*)(jb.src + (size_t)k * jb.ld_src + 4 * c4)); cur[2 * p + 1] = __builtin_nontemporal_load((const f32x4*)(jb.src + (size_t)(k + 1) * jb.ld_src + 4 * c4)); } }
  int buf = 0;
  for (; tile < total; tile += stride) {
    const int ntile = tile + stride;
    CvtJob nj = jb;
    if (ntile < total) { nj = cvt_decode(P, ntile);
#pragma unroll
      for (int p = 0; p < 2; ++p) { const int k = 64 * p + 2 * kr; nxt[2 * p] = __builtin_nontemporal_load((const f32x4*)(nj.src + (size_t)k * nj.ld_src + 4 * c4)); nxt[2 * p + 1] = __builtin_nontemporal_load((const f32x4*)(nj.src + (size_t)(k + 1) * nj.ld_src + 4 * c4)); } }
    LAS unsigned char* L = lds + buf * 16896;
#pragma unroll
    for (int p = 0; p < 2; ++p) {
      const int k = 64 * p + 2 * kr;
      float g0 = 1.f, g1 = 1.f;
      if (jb.gain) { g0 = jb.gain[k]; g1 = jb.gain[k + 1]; }
#pragma unroll
      for (int i = 0; i < 4; ++i) {
        const int sc = 4 * c4 + i; const int n = jb.perm ? ((sc < 32) ? 2 * sc : 2 * (sc - 32) + 1) : sc;
        *(LAS unsigned*)(L + n * 264 + k * 2) = cvt_pk_bf16(cur[2 * p][i] * g0, cur[2 * p + 1][i] * g1);
      }
    }
    __syncthreads();
#pragma unroll
    for (int i = 0; i < 4; ++i) {
      const int pc = tid + 512 * i, n = pc >> 5, kc = pc & 31;
      const u32x2 v = *(const LAS u32x2*)(L + n * 264 + kc * 8);
      *(u32x2*)(jb.dst + (size_t)n * jb.ld_dst + kc * 4) = v;
    }
    buf ^= 1; jb = nj;
#pragma unroll
    for (int i = 0; i < 4; ++i) cur[i] = nxt[i];
  }
  __syncthreads();
}
DI void phase_convert(KParams P, LAS unsigned char* lds) {
  convert_tiles(P, lds, blockIdx.x, gridDim.x, (gridDim.x == 256) ? CVT_TOTAL - CVT_DEFER : CVT_TOTAL);
  const int gtid = blockIdx.x * 512 + tid_fresh(), gsz = gridDim.x * 512;
  for (int i = gtid; i < T_TOK * 32; i += gsz) {
    const int t = i >> 5, f = i & 31;
    const float ang = (float)P->pos[t] * P->inv_freq[f];
    double rev = (double)ang * 0.15915494309189535; rev -= rint(rev);
    const float rf = (float)rev;
    P->cs[2 * i] = __builtin_amdgcn_cosf(rf); P->cs[2 * i + 1] = __builtin_amdgcn_sinf(rf);
  }
  for (int i = gtid; i < DM; i += gsz) P->sp8[i] = 8.f * log1pf(__expf(-P->rlam[i]));
  for (int i = gtid; i < 5 * T_TOK; i += gsz) P->ssq[i] = 0ull;
}

DI void phase_rmsnorm(const float* src, const float* g, bf16_t* dst, float* fout) {
  const int lane = tid_fresh() & 63, wid = tid_fresh() >> 6;
  f32x4 gv[8];
#pragma unroll
  for (int j = 0; j < 8; ++j) gv[j] = *(const f32x4*)(g + (j * 64 + lane) * 4);
  for (int row = blockIdx.x * 8 + wid; row < T_TOK; row += gridDim.x * 8) {
    const float* p = src + (size_t)row * DM;
    f32x4 v[8]; float ss = 0.f;
#pragma unroll
    for (int j = 0; j < 8; ++j) { v[j] = *(const f32x4*)(p + (j * 64 + lane) * 4); ss += v[j][0] * v[j][0] + v[j][1] * v[j][1] + v[j][2] * v[j][2] + v[j][3] * v[j][3]; }
    ss = wave_sum(ss);
    const float rs = rsqrtf(ss * (1.f / DM) + 1e-6f);
    if (fout) {
#pragma unroll
      for (int j = 0; j < 8; ++j) *(f32x4*)(fout + (size_t)row * DM + (j * 64 + lane) * 4) = v[j] * rs * gv[j];
    } else {
#pragma unroll
      for (int j = 0; j < 8; ++j) { const f32x4 o = v[j] * rs * gv[j]; u32x2 w; w.x = cvt_pk_bf16(o[0], o[1]); w.y = cvt_pk_bf16(o[2], o[3]); *(u32x2*)(dst + (size_t)row * DM + (j * 64 + lane) * 4) = w; }
    }
  }
}

DI void phase_prep(KParams P, bf16_t* lat) {
  const int lane = tid_fresh() & 63, wid = tid_fresh() >> 6;
  for (int row = blockIdx.x * 8 + wid; row < T_TOK; row += gridDim.x * 8) {
    bf16_t* p = lat + (size_t)row * 1536;
    u32x2 a[3], b[2]; float s1 = 0.f, s2 = 0.f;
#pragma unroll
    for (int j = 0; j < 3; ++j) { a[j] = *(const u32x2*)(p + (j * 64 + lane) * 4); const float x0 = bf_lo(a[j].x), x1 = bf_hi(a[j].x), x2 = bf_lo(a[j].y), x3 = bf_hi(a[j].y); s1 += x0 * x0 + x1 * x1 + x2 * x2 + x3 * x3; }
#pragma unroll
    for (int j = 0; j < 2; ++j) { b[j] = *(const u32x2*)(p + 768 + (j * 64 + lane) * 4); const float x0 = bf_lo(b[j].x), x1 = bf_hi(b[j].x), x2 = bf_lo(b[j].y), x3 = bf_hi(b[j].y); s2 += x0 * x0 + x1 * x1 + x2 * x2 + x3 * x3; }
    const float kr = bf2f(p[1280 + lane]);
    s1 = wave_sum(s1); s2 = wave_sum(s2);
    const float r1 = rsqrtf(s1 * (1.f / 768.f) + 1e-6f), r2 = rsqrtf(s2 * (1.f / 512.f) + 1e-6f);
#pragma unroll
    for (int j = 0; j < 3; ++j) { const f32x4 g = *(const f32x4*)(P->q_norm + (j * 64 + lane) * 4);
      u32x2 w; w.x = cvt_pk_bf16(bf_lo(a[j].x) * r1 * g[0], bf_hi(a[j].x) * r1 * g[1]); w.y = cvt_pk_bf16(bf_lo(a[j].y) * r1 * g[2], bf_hi(a[j].y) * r1 * g[3]); *(u32x2*)(p + (j * 64 + lane) * 4) = w; }
#pragma unroll
    for (int j = 0; j < 2; ++j) { const f32x4 g = *(const f32x4*)(P->kv_norm + (j * 64 + lane) * 4);
      u32x2 w; w.x = cvt_pk_bf16(bf_lo(b[j].x) * r2 * g[0], bf_hi(b[j].x) * r2 * g[1]); w.y = cvt_pk_bf16(bf_lo(b[j].y) * r2 * g[2], bf_hi(b[j].y) * r2 * g[3]); *(u32x2*)(p + 768 + (j * 64 + lane) * 4) = w; }
    const float other = __shfl_xor(kr, 32);
    const int i = lane & 31;
    const float c = P->cs[((size_t)row * 32 + i) * 2], s = P->cs[((size_t)row * 32 + i) * 2 + 1];
    const float o = (lane < 32) ? (kr * c - other * s) : (kr * c + other * s);
    p[1280 + 2 * i + (lane >> 5)] = (bf16_t)(cvt_pk_bf16(o, 0.f) & 0xffffu);
  }
}

DI void phase_conv(KParams P, const bf16_t* xr, bf16_t* xc) {
  for (int it = blockIdx.x * 512 + tid_fresh(); it < (T_TOK / 8) * 256; it += gridDim.x * 512) {
    const int chg = it & 255, tg = it >> 8, t0 = tg * 8, ch = chg * 8;
    float w[4][8], bias[8];
#pragma unroll
    for (int j = 0; j < 4; ++j) { const f32x4 a = *(const f32x4*)(P->conv_w + j * DM + ch), b = *(const f32x4*)(P->conv_w + j * DM + ch + 4);
#pragma unroll
      for (int e = 0; e < 4; ++e) { w[j][e] = a[e]; w[j][4 + e] = b[e]; } }
    { const f32x4 a = *(const f32x4*)(P->conv_b + ch), b = *(const f32x4*)(P->conv_b + ch + 4);
#pragma unroll
      for (int e = 0; e < 4; ++e) { bias[e] = a[e]; bias[4 + e] = b[e]; } }
    float win[3][8];
    const bool first = (t0 & (SEQ - 1)) == 0;
#pragma unroll
    for (int j = 0; j < 3; ++j) {
      u32x4 v = (u32x4){0u, 0u, 0u, 0u};
      if (!first) v = *(const u32x4*)(xr + (size_t)(t0 - 3 + j) * DM + ch);
      win[j][0] = bf_lo(v.x); win[j][1] = bf_hi(v.x); win[j][2] = bf_lo(v.y); win[j][3] = bf_hi(v.y); win[j][4] = bf_lo(v.z); win[j][5] = bf_hi(v.z); win[j][6] = bf_lo(v.w); win[j][7] = bf_hi(v.w);
    }
#pragma unroll
    for (int t = 0; t < 8; ++t) {
      const u32x4 v = *(const u32x4*)(xr + (size_t)(t0 + t) * DM + ch);
      float cur[8]; cur[0] = bf_lo(v.x); cur[1] = bf_hi(v.x); cur[2] = bf_lo(v.y); cur[3] = bf_hi(v.y); cur[4] = bf_lo(v.z); cur[5] = bf_hi(v.z); cur[6] = bf_lo(v.w); cur[7] = bf_hi(v.w);
      float o[8];
#pragma unroll
      for (int e = 0; e < 8; ++e) o[e] = bias[e] + w[0][e] * win[0][e] + w[1][e] * win[1][e] + w[2][e] * win[2][e] + w[3][e] * cur[e];
      u32x4 wv; wv.x = cvt_pk_bf16(o[0], o[1]); wv.y = cvt_pk_bf16(o[2], o[3]); wv.z = cvt_pk_bf16(o[4], o[5]); wv.w = cvt_pk_bf16(o[6], o[7]);
      *(u32x4*)(xc + (size_t)(t0 + t) * DM + ch) = wv;
#pragma unroll
      for (int e = 0; e < 8; ++e) { win[0][e] = win[1][e]; win[1][e] = win[2][e]; win[2][e] = cur[e]; }
    }
  }
}

DI void unpack8(const u32x4 v, float* f) { f[0] = bf_lo(v.x); f[1] = bf_hi(v.x); f[2] = bf_lo(v.y); f[3] = bf_hi(v.y); f[4] = bf_lo(v.z); f[5] = bf_hi(v.z); f[6] = bf_lo(v.w); f[7] = bf_hi(v.w); }
DI void phase_scan1(const bf16_t* la, const bf16_t* bb, float* asum, float* hend) {
  for (int it = blockIdx.x * 512 + tid_fresh(); it < NB * 128 * 256; it += gridDim.x * 512) {
    const int chg = it & 255, c = (it >> 8) & 127, b = it >> 15;
    const size_t base = ((size_t)b * SEQ + c * 32) * DM + chg * 8;
    float h[8], as[8];
#pragma unroll
    for (int e = 0; e < 8; ++e) { h[e] = 0.f; as[e] = 0.f; }
#pragma unroll 8
    for (int t = 0; t < 32; ++t) {
      float l[8], bv[8]; unpack8(*(const u32x4*)(la + base + (size_t)t * DM), l); unpack8(*(const u32x4*)(bb + base + (size_t)t * DM), bv);
#pragma unroll
      for (int e = 0; e < 8; ++e) { h[e] = __expf(l[e]) * h[e] + bv[e]; as[e] += l[e]; }
    }
    const size_t so = ((size_t)b * 128 + c) * DM + chg * 8;
    *(f32x4*)(asum + so) = (f32x4){as[0], as[1], as[2], as[3]}; *(f32x4*)(asum + so + 4) = (f32x4){as[4], as[5], as[6], as[7]};
    *(f32x4*)(hend + so) = (f32x4){h[0], h[1], h[2], h[3]}; *(f32x4*)(hend + so + 4) = (f32x4){h[4], h[5], h[6], h[7]};
  }
}
DI void phase_scan_carry(const float* asum, float* hend) {
  for (int it = blockIdx.x * 512 + tid_fresh(); it < NB * DM; it += gridDim.x * 512) {
    const int ch = it & (DM - 1), b = it >> 11;
    float H = 0.f;
    for (int c0 = 0; c0 < 128; c0 += 16) {
      float a[16], he[16];
#pragma unroll
      for (int i = 0; i < 16; ++i) { const size_t o = ((size_t)b * 128 + c0 + i) * DM + ch; a[i] = asum[o]; he[i] = hend[o]; }
#pragma unroll
      for (int i = 0; i < 16; ++i) { const size_t o = ((size_t)b * 128 + c0 + i) * DM + ch; hend[o] = H; H = __expf(a[i]) * H + he[i]; }
    }
  }
}
DI void phase_scan2(const bf16_t* la, const bf16_t* bb, const bf16_t* y, const float* hin, bf16_t* yh) {
  for (int it = blockIdx.x * 512 + tid_fresh(); it < NB * 128 * 256; it += gridDim.x * 512) {
    const int chg = it & 255, c = (it >> 8) & 127, b = it >> 15;
    const size_t base = ((size_t)b * SEQ + c * 32) * DM + chg * 8;
    const size_t so = ((size_t)b * 128 + c) * DM + chg * 8;
    float h[8];
    { const f32x4 a = *(const f32x4*)(hin + so), bq = *(const f32x4*)(hin + so + 4);
#pragma unroll
      for (int e = 0; e < 4; ++e) { h[e] = a[e]; h[4 + e] = bq[e]; } }
#pragma unroll 8
    for (int t = 0; t < 32; ++t) {
      float l[8], bv[8], yv[8]; unpack8(*(const u32x4*)(la + base + (size_t)t * DM), l); unpack8(*(const u32x4*)(bb + base + (size_t)t * DM), bv); unpack8(*(const u32x4*)(y + base + (size_t)t * DM), yv);
      float o[8];
#pragma unroll
      for (int e = 0; e < 8; ++e) { h[e] = __expf(l[e]) * h[e] + bv[e]; o[e] = h[e] * yv[e]; }
      u32x4 wv; wv.x = cvt_pk_bf16(o[0], o[1]); wv.y = cvt_pk_bf16(o[2], o[3]); wv.z = cvt_pk_bf16(o[4], o[5]); wv.w = cvt_pk_bf16(o[6], o[7]);
      *(u32x4*)(yh + base + (size_t)t * DM) = wv;
    }
  }
}

DI void glds16(const void* gsrc, unsigned lds_dst) { unsigned keep;
  asm volatile("s_mov_b32 %0, m0\n\ts_mov_b32 m0, %2\n\ts_nop 0\n\tglobal_load_lds_dwordx4 %1, off\n\ts_mov_b32 m0, %0" : "=&s"(keep) : "v"(gsrc), "s"(lds_dst) : "memory"); }
DI float max3f(float a, float b, float c) { float r; asm("v_max3_f32 %0, %1, %2, %3" : "=v"(r) : "v"(a), "v"(b), "v"(c)); return r; }
struct AttnSrc {
  const bf16_t* q; int ldq;
  const bf16_t* k0; int ldk0; int nk0;
  const bf16_t* k1; int ldk1;
  const bf16_t* v; int ldv;
};
template <int DK>
DI void attn_pass(const AttnSrc& s, const int q0, const float sc, LAS unsigned char* lds, f32x16 (&O)[4]) {
  constexpr int ROWB = DK * 2, KSZ = 64 * ROWB, VSZ = 16384, KP = KSZ / 8192, NS = DK / 16, STG = KSZ + VSZ, NBUF = (DK == 64) ? 4 : 3, DPF = NBUF - 1, PT = KP + 2;
  const int tid = tid_fresh(), lane = tid & 63, wid = __builtin_amdgcn_readfirstlane(tid >> 6), r = lane & 31, h = lane >> 5;
  const int qw0 = q0 + wid * 32;
  asm volatile("s_waitcnt vmcnt(0)" ::: "memory");
#pragma unroll
  for (int i = 0; i < 4; ++i)
#pragma unroll
    for (int j = 0; j < 16; ++j) O[i][j] = 0.f;
  float mrun = (DK == 64) ? 0.f : -INFINITY, lrun = 0.f;
  const int NT = (q0 + 256) / 64;
  const bf16_t* kp[KP]; int kstr[KP]; const bf16_t* vp[2];
#pragma unroll
  for (int i = 0; i < KP; ++i) {
    const int o = (wid + 8 * i) * 1024 + lane * 16, row = o / ROWB, pc = (o % ROWB) >> 4;
    const int lc = (DK == 64) ? (pc ^ (row & 7)) : ((pc & ~7) | ((pc & 7) ^ ((row >> 1) & 7)));
    const int e = lc * 8;
    if (e < s.nk0) { kp[i] = s.k0 + (size_t)row * s.ldk0 + e; kstr[i] = 64 * s.ldk0; } else { kp[i] = s.k1 + (size_t)row * s.ldk1 + (e - s.nk0); kstr[i] = 64 * s.ldk1; }
  }
#pragma unroll
  for (int i = 0; i < 2; ++i) {
    const int o = (wid + 8 * i) * 1024 + lane * 16, row = o >> 8, pc = (o >> 4) & 15;
    const int lc = (((pc >> 2) ^ (row & 3)) << 2) | (pc & 3);
    vp[i] = s.v + (size_t)row * s.ldv + lc * 8;
  }
  const int vstr = 64 * s.ldv;
  const unsigned lds0 = (unsigned)reinterpret_cast<__UINTPTR_TYPE__>(lds);
  auto issue = [&](int t, int buf) {
#pragma unroll
    for (int i = 0; i < KP; ++i) glds16(kp[i] + (size_t)t * kstr[i], (unsigned)__builtin_amdgcn_readfirstlane(lds0 + buf * STG + (wid + 8 * i) * 1024));
#pragma unroll
    for (int i = 0; i < 2; ++i) glds16(vp[i] + (size_t)t * vstr, (unsigned)__builtin_amdgcn_readfirstlane(lds0 + buf * STG + KSZ + (wid + 8 * i) * 1024));
  };
#pragma unroll
  for (int i = 0; i < DPF; ++i) issue(i, i);
  bf16x8 qf[NS];
#pragma unroll
  for (int i = 0; i < NS; ++i) qf[i] = *(const bf16x8*)(s.q + (size_t)(qw0 + r) * s.ldq + 16 * i + 8 * h);
#pragma unroll
  for (int i = 0; i < NS; ++i) asm volatile("" : "+v"(qf[i]));
  constexpr bool REL = (DK == 64);
  if (REL) {
#pragma unroll
  for (int i = 0; i < NS; ++i) {
    const u32x4 w = __builtin_bit_cast(u32x4, qf[i]); u32x4 o;
    o.x = cvt_pk_bf16(bf_lo(w.x) * sc, bf_hi(w.x) * sc); o.y = cvt_pk_bf16(bf_lo(w.y) * sc, bf_hi(w.y) * sc);
    o.z = cvt_pk_bf16(bf_lo(w.z) * sc, bf_hi(w.z) * sc); o.w = cvt_pk_bf16(bf_lo(w.w) * sc, bf_hi(w.w) * sc);
    qf[i] = __builtin_bit_cast(bf16x8, o);
  }
  }
  f32x16 negm;
#pragma unroll
  for (int j = 0; j < 16; ++j) negm[j] = 0.f;
  if (REL) asm volatile("" : "+v"(negm));
  const int kx = (DK == 64) ? (r & 7) : ((r >> 1) & 7);
  const int krow = r * ROWB;
  const int i15 = lane & 15;
  const int vrow = (4 * h + (i15 >> 2)) * 256 + ((lane >> 4) & 1) * 32 + (lane & 3) * 8;
  const int vx = (i15 >> 2) & 3;
  int buf = 0, pbuf = DPF;
  for (int t = 0; t < NT; ++t) {
    { const int rem = NT - 1 - t;
      if (rem >= DPF - 1) asm volatile("s_waitcnt vmcnt(%0)" :: "n"((DPF - 1) * PT) : "memory");
      else if (rem == 1) asm volatile("s_waitcnt vmcnt(%0)" :: "n"(PT) : "memory");
      else asm volatile("s_waitcnt vmcnt(0)" ::: "memory"); }
    __builtin_amdgcn_s_barrier();
    asm volatile("" ::: "memory");
    if (t + DPF < NT) issue(t + DPF, pbuf);
    if (64 * t <= qw0 + 31) {
      LAS unsigned char* Kb = lds + buf * STG; LAS unsigned char* Vb = lds + buf * STG + KSZ;
      f32x16 p0, p1;
      constexpr int GS = (DK == 64) ? 4 : 2, NG = NS / GS;
      bf16x8 kfa[2][GS], kfb[2][GS];
      auto kload = [&](int g, int slot) {
#pragma unroll
        for (int j = 0; j < GS; ++j) { const int lc = 2 * (g * GS + j) + h; const int ph = (DK == 64) ? (lc ^ kx) : ((lc & ~7) | ((lc & 7) ^ kx));
          kfa[slot][j] = *(const LAS bf16x8*)(Kb + krow + ph * 16); kfb[slot][j] = *(const LAS bf16x8*)(Kb + krow + 32 * ROWB + ph * 16); }
      };
      kload(0, 0);
#pragma unroll
      for (int g = 0; g < NG; ++g) {
        if (g + 1 < NG) kload(g + 1, (g + 1) & 1);
        __builtin_amdgcn_s_setprio(1);
#pragma unroll
        for (int j = 0; j < GS; ++j) {
          if (g == 0 && j == 0) {
            if (REL) {
              p0 = __builtin_amdgcn_mfma_f32_32x32x16_bf16(kfa[0][0], qf[0], negm, 0, 0, 0);
              p1 = __builtin_amdgcn_mfma_f32_32x32x16_bf16(kfb[0][0], qf[0], negm, 0, 0, 0);
            } else {
              f32x16 z;
#pragma unroll
              for (int jj = 0; jj < 16; ++jj) z[jj] = 0.f;
              p0 = __builtin_amdgcn_mfma_f32_32x32x16_bf16(kfa[0][0], qf[0], z, 0, 0, 0);
              p1 = __builtin_amdgcn_mfma_f32_32x32x16_bf16(kfb[0][0], qf[0], z, 0, 0, 0);
            }
          } else {
            p0 = __builtin_amdgcn_mfma_f32_32x32x16_bf16(kfa[g & 1][j], qf[g * GS + j], p0, 0, 0, 0);
            p1 = __builtin_amdgcn_mfma_f32_32x32x16_bf16(kfb[g & 1][j], qf[g * GS + j], p1, 0, 0, 0);
          }
        }
        __builtin_amdgcn_s_setprio(0);
      }
      bf16x8 vf[2][4];
      auto vload = [&](int vt, int slot) {
        const int vcol = vrow + ((vt ^ vx) << 6);
#pragma unroll
        for (int ks = 0; ks < 4; ++ks) {
          const s16x4 lo = __builtin_bit_cast(s16x4, __builtin_amdgcn_ds_read_tr16_b64_v4i16((LAS s16x4*)(Vb + vcol + ks * 16 * 256)));
          const s16x4 hi = __builtin_bit_cast(s16x4, __builtin_amdgcn_ds_read_tr16_b64_v4i16((LAS s16x4*)(Vb + vcol + (ks * 16 + 8) * 256)));
          vf[slot][ks] = __builtin_shufflevector(lo, hi, 0, 1, 2, 3, 4, 5, 6, 7);
        }
      };
      vload(0, 0);
      if (64 * t + 63 > qw0) {
        const int qa = qw0 + r, kbase = 64 * t + 4 * h;
#pragma unroll
        for (int j = 0; j < 16; ++j) { const int kv = kbase + (j & 3) + 8 * (j >> 2); if (kv > qa) p0[j] = -INFINITY; if (kv + 32 > qa) p1[j] = -INFINITY; }
      }
      asm volatile("s_nop 15\n\ts_nop 7" : "+v"(p0), "+v"(p1));
      float mx;
      { float ma = max3f(p0[0], p0[1], p1[0]), mb = max3f(p0[2], p0[3], p1[1]); ma = max3f(ma, p1[2], p1[3]);
#pragma unroll
        for (int j = 4; j < 16; j += 4) { ma = max3f(ma, p0[j], p0[j + 1]); mb = max3f(mb, p0[j + 2], p0[j + 3]); ma = max3f(ma, p1[j], p1[j + 1]); mb = max3f(mb, p1[j + 2], p1[j + 3]); }
        mx = fmaxf(ma, mb); }
      { auto rr = __builtin_amdgcn_permlane32_swap(__float_as_uint(mx), __float_as_uint(mx), false, false); mx = fmaxf(__uint_as_float(rr[0]), __uint_as_float(rr[1])); }
      float rs = 0.f;
      if (REL) {
        const bool grow = (mx > 8.f) || (t == 0);
        if (__builtin_amdgcn_ballot_w64(grow) != 0ull) {
          const float dl = grow ? mx : 0.f;
          const float alpha = __builtin_amdgcn_exp2f(-dl);
          mrun += dl; lrun *= alpha;
#pragma unroll
          for (int j = 0; j < 16; ++j) { p0[j] -= dl; p1[j] -= dl; negm[j] = -mrun; }
          asm volatile("" : "+v"(negm));
#pragma unroll
          for (int i = 0; i < 4; ++i)
#pragma unroll
            for (int j = 0; j < 16; ++j) O[i][j] *= alpha;
        }
#pragma unroll
        for (int j = 0; j < 16; ++j) { p0[j] = __builtin_amdgcn_exp2f(p0[j]); p1[j] = __builtin_amdgcn_exp2f(p1[j]); rs += p0[j] + p1[j]; }
      } else {
        const float cand = mx * sc;
        const bool grow = cand > mrun + 8.f;
        if (__builtin_amdgcn_ballot_w64(grow) != 0ull) {
          const float mnew = grow ? cand : mrun;
          const float alpha = __builtin_amdgcn_exp2f(mrun - mnew);
          mrun = mnew; lrun *= alpha;
#pragma unroll
          for (int i = 0; i < 4; ++i)
#pragma unroll
            for (int j = 0; j < 16; ++j) O[i][j] *= alpha;
        }
#pragma unroll
        for (int j = 0; j < 16; ++j) { p0[j] = __builtin_amdgcn_exp2f(p0[j] * sc - mrun); p1[j] = __builtin_amdgcn_exp2f(p1[j] * sc - mrun); rs += p0[j] + p1[j]; }
      }
      lrun += rs;
      bf16x8 pb[4];
      { u32x4 w;
        w.x = cvt_pk_bf16(p0[0], p0[1]); w.y = cvt_pk_bf16(p0[2], p0[3]); w.z = cvt_pk_bf16(p0[4], p0[5]); w.w = cvt_pk_bf16(p0[6], p0[7]); pb[0] = __builtin_bit_cast(bf16x8, w);
        w.x = cvt_pk_bf16(p0[8], p0[9]); w.y = cvt_pk_bf16(p0[10], p0[11]); w.z = cvt_pk_bf16(p0[12], p0[13]); w.w = cvt_pk_bf16(p0[14], p0[15]); pb[1] = __builtin_bit_cast(bf16x8, w);
        w.x = cvt_pk_bf16(p1[0], p1[1]); w.y = cvt_pk_bf16(p1[2], p1[3]); w.z = cvt_pk_bf16(p1[4], p1[5]); w.w = cvt_pk_bf16(p1[6], p1[7]); pb[2] = __builtin_bit_cast(bf16x8, w);
        w.x = cvt_pk_bf16(p1[8], p1[9]); w.y = cvt_pk_bf16(p1[10], p1[11]); w.z = cvt_pk_bf16(p1[12], p1[13]); w.w = cvt_pk_bf16(p1[14], p1[15]); pb[3] = __builtin_bit_cast(bf16x8, w); }
#pragma unroll
      for (int vt = 0; vt < 4; ++vt) {
        if (vt + 1 < 4) vload(vt + 1, (vt + 1) & 1);
        __builtin_amdgcn_s_setprio(1);
#pragma unroll
        for (int ks = 0; ks < 4; ++ks) O[vt] = __builtin_amdgcn_mfma_f32_32x32x16_bf16(vf[vt & 1][ks], pb[ks], O[vt], 0, 0, 0);
        __builtin_amdgcn_s_setprio(0);
      }
    }
    buf = (buf + 1 == NBUF) ? 0 : buf + 1; pbuf = (pbuf + 1 == NBUF) ? 0 : pbuf + 1;
  }
  asm volatile("s_waitcnt lgkmcnt(0)" ::: "memory");
  __builtin_amdgcn_s_barrier();
  asm volatile("" ::: "memory");
  float lt; { auto rr = __builtin_amdgcn_permlane32_swap(__float_as_uint(lrun), __float_as_uint(lrun), false, false); lt = __uint_as_float(rr[0]) + __uint_as_float(rr[1]); }
  const float inv = 1.f / lt;
#pragma unroll
  for (int i = 0; i < 4; ++i)
#pragma unroll
    for (int j = 0; j < 16; ++j) O[i][j] *= inv;
}

DI void attn_store(const f32x16 (&O)[4], bf16_t* dst, int qrow, int h) {
#pragma unroll
  for (int vt = 0; vt < 4; ++vt)
#pragma unroll
    for (int g = 0; g < 4; ++g) {
      u32x2 w; w.x = cvt_pk_bf16(O[vt][4 * g], O[vt][4 * g + 1]); w.y = cvt_pk_bf16(O[vt][4 * g + 2], O[vt][4 * g + 3]);
      *(u32x2*)(dst + (size_t)qrow * DM + 32 * vt + 8 * g + 4 * h) = w;
    }
}

DI void phase_attention(KParams P, LAS unsigned char* lds) {
  const bf16_t* qkva = P->X; const bf16_t* lat = P->X + (size_t)T_TOK * 3072; const bf16_t* qb_ = lat + (size_t)T_TOK * 1536; const bf16_t* kv = qb_ + (size_t)T_TOK * 1536;
  const int lane = tid_fresh() & 63, wid = tid_fresh() >> 6, r = lane & 31, h = lane >> 5;
  float lam;
  { const float s1 = wave_sum(P->lq1[lane] * P->lk1[lane]), s2 = wave_sum(P->lq2[lane] * P->lk2[lane]); lam = __expf(s1) - __expf(s2) + 0.2f; }
  const int G = gridDim.x;
  const int vb = ((int)blockIdx.x % 8) * (G / 8) + (int)blockIdx.x / 8;
  const float LOG2E = 1.4426950408889634f;
#ifndef ATTN_NO_A
  for (int it = vb; it < 256; it += G) {
    const int bh = it >> 3, sidx = it & 7, b = bh >> 3, head = bh & 7;
#pragma unroll 1
    for (int half = 0; half < 2; ++half) {
      const int qb = half ? 15 - sidx : sidx, q0 = qb * 256;
      const size_t rb = (size_t)b * SEQ;
      unsigned o1p[4][8];
      f32x16 O[4];
#pragma unroll 1
      for (int map = 0; map < 2; ++map) {
        AttnSrc s;
        s.q = qkva + rb * 3072 + head * 128 + map * 64; s.ldq = 3072;
        s.k0 = qkva + rb * 3072 + 1024 + head * 128 + map * 64; s.ldk0 = 3072; s.nk0 = 64; s.k1 = s.k0; s.ldk1 = 3072;
        s.v = qkva + rb * 3072 + 2048 + head * 128; s.ldv = 3072;
        attn_pass<64>(s, q0, 0.125f * LOG2E, lds, O);
        if (map == 0) {
#pragma unroll
          for (int i = 0; i < 4; ++i)
#pragma unroll
            for (int j = 0; j < 8; ++j) o1p[i][j] = cvt_pk_bf16(O[i][2 * j], O[i][2 * j + 1]);
        }
      }
      float ss = 0.f;
#pragma unroll
      for (int i = 0; i < 4; ++i)
#pragma unroll
        for (int j = 0; j < 8; ++j) { const float a = bf_lo(o1p[i][j]) - lam * O[i][2 * j], c = bf_hi(o1p[i][j]) - lam * O[i][2 * j + 1]; O[i][2 * j] = a; O[i][2 * j + 1] = c; ss += a * a + c * c; }
      ss += __shfl_xor(ss, 32);
      const float rs = rsqrtf(ss * (1.f / 128.f) + 1e-5f) * 0.8f;
#pragma unroll
      for (int i = 0; i < 4; ++i)
#pragma unroll
        for (int g = 0; g < 4; ++g) { const f32x4 gn = *(const f32x4*)(P->subln + 32 * i + 8 * g + 4 * h);
#pragma unroll
          for (int e = 0; e < 4; ++e) O[i][4 * g + e] *= rs * gn[e]; }
      attn_store(O, P->act + rb * DM + head * 128, q0 + wid * 32 + r, h);
    }
  }
#endif
#ifndef ATTN_NO_B
  for (int it = vb; it < 256; it += G) {
    const int bh = it >> 3, sidx = it & 7, b = bh >> 3, head = bh & 7;
#pragma unroll 1
    for (int half = 0; half < 2; ++half) {
      const int qb = half ? 15 - sidx : sidx, q0 = qb * 256;
      const size_t rb = (size_t)b * SEQ;
      f32x16 O[4];
      AttnSrc s;
      s.q = qb_ + rb * 1536 + head * 192; s.ldq = 1536;
      s.k0 = kv + rb * 2048 + head * 256; s.ldk0 = 2048; s.nk0 = 128; s.k1 = lat + rb * 1536 + 1280; s.ldk1 = 1536;
      s.v = kv + rb * 2048 + head * 256 + 128; s.ldv = 2048;
      attn_pass<192>(s, q0, 0.07216878364870322f * LOG2E, lds, O);
      attn_store(O, P->act + rb * DM + 1024 + head * 128, q0 + wid * 32 + r, h);
    }
  }
#endif
}

#define XB_TMO      128
#define XB_XCNT(j)  (256  + 64 * (j))
#define XB_XSUB(j)  (1280 + 64 * (j))
#define XB_XGEN(j)  (2304 + 64 * (j))
#define XB_TOP      3328
#define XB_TOPGEN   3392
#define XCD_BAR_WORDS 3456
#define XB_SPIN_CAP (1u << 18)

__device__ __forceinline__ unsigned xb_ld(unsigned* p)              { return __hip_atomic_load(p, __ATOMIC_RELAXED, __HIP_MEMORY_SCOPE_AGENT); }
__device__ __forceinline__ unsigned xb_add(unsigned* p, unsigned v) { return __hip_atomic_fetch_add(p, v, __ATOMIC_RELAXED, __HIP_MEMORY_SCOPE_AGENT); }
__device__ __forceinline__ unsigned xb_xcc_id() { return (unsigned)__builtin_amdgcn_s_getreg((3 << 11) | 20) & 0xFu; }
#define XB_SPIN(cond, bar) do { unsigned _sp = 0; while (cond) { __builtin_amdgcn_s_sleep(1); \
    if ((++_sp & 255u) == 0u) { if (xb_ld(&(bar)[XB_TMO])) break; if (_sp > XB_SPIN_CAP) { atomicAdd(&(bar)[XB_TMO], 1u); break; } } } } while (0)

struct XcdBarrier {
    unsigned* bar; unsigned x;
    volatile LAS unsigned* st;
};

__device__ __forceinline__ XcdBarrier xcd_barrier_post(unsigned* bar, volatile LAS unsigned* st) {
    XcdBarrier b; b.bar = bar; b.x = xb_xcc_id(); b.st = st;
    if (threadIdx.x == 0) (void)xb_add(&bar[XB_XCNT(b.x)], 1u);
    return b;
}
__device__ __forceinline__ void xcd_barrier_complete(unsigned* bar, unsigned x, unsigned& nloc, unsigned& nx) {
    const unsigned G = gridDim.x * gridDim.y * gridDim.z;
    unsigned sum, cnt, mine, sp = 0u;
    for (;;) {
        sum = 0u; cnt = 0u; mine = 0u;
#pragma unroll
        for (unsigned j = 0; j < 16; ++j) { const unsigned c = xb_ld(&bar[XB_XCNT(j)]); sum += c; cnt += (c > 0u) ? 1u : 0u; mine = (j == x) ? c : mine; }
        if (sum == G) break;
        __builtin_amdgcn_s_sleep(1);
        if ((++sp & 255u) == 0u) { if (xb_ld(&bar[XB_TMO])) break; if (sp > XB_SPIN_CAP) { atomicAdd(&bar[XB_TMO], 1u); break; } }
    }
    nloc = mine > 0u ? mine : 1u; nx = cnt > 0u ? cnt : 1u;
}

__device__ __forceinline__ void xcd_barrier(const XcdBarrier& b) {
    asm volatile("s_waitcnt vmcnt(0)" ::: "memory");
    __syncthreads();
    if (threadIdx.x == 0) {
        unsigned* bar = b.bar;
        __builtin_amdgcn_s_waitcnt(0);
        unsigned nloc = b.st[0], nx = b.st[1];
        if (nloc == 0u) { xcd_barrier_complete(bar, b.x, nloc, nx); b.st[0] = nloc; b.st[1] = nx; }
        const unsigned old = xb_add(&bar[XB_XSUB(b.x)], 1u);
        const unsigned gen = old / nloc;
        if (old + 1u == (gen + 1u) * nloc) {
            __builtin_amdgcn_fence(__ATOMIC_RELEASE, "agent");
            asm volatile("s_waitcnt vmcnt(0)" ::: "memory");
            const unsigned og = xb_add(&bar[XB_TOP], 1u);
            const unsigned tg = og / nx;
            if (og + 1u == (tg + 1u) * nx) xb_add(&bar[XB_TOPGEN], 1u);
            else XB_SPIN(xb_ld(&bar[XB_TOPGEN]) == tg, bar);
            __builtin_amdgcn_fence(__ATOMIC_ACQUIRE, "agent");
            xb_add(&bar[XB_XGEN(b.x)], 1u);
            asm volatile("s_waitcnt vmcnt(0)" ::: "memory");
        } else {
            XB_SPIN(xb_ld(&bar[XB_XGEN(b.x)]) == gen, bar);
            __builtin_amdgcn_fence(__ATOMIC_ACQUIRE, "agent");
            asm volatile("s_waitcnt vmcnt(0)" ::: "memory");
        }
    }
    __syncthreads();
}


constexpr int NSTEP = 22;
__global__ void __launch_bounds__(512, 2) fwd_kernel(Params Parg) {
  extern __shared__ __attribute__((aligned(16))) unsigned char shm[];
  LAS unsigned char* lds = (LAS unsigned char*)shm;
  KParams Pk = (KParams)__builtin_amdgcn_kernarg_segment_ptr();
  const int step_lo = Pk->step_lo, step_hi = Pk->step_hi;
  volatile LAS unsigned* xst = (volatile LAS unsigned*)(lds + LDS_BYTES);
  if (threadIdx.x == 0) { xst[0] = 0u; xst[1] = 0u; }
  __syncthreads();
  const XcdBarrier xb = xcd_barrier_post(Pk->bar, xst);
#ifndef REPEAT_MASK
#define REPEAT_MASK 0
#endif
#ifndef EXTRA_SYNCS
#define EXTRA_SYNCS 0
#endif
  for (int st2 = 2 * step_lo; st2 < 2 * step_hi; ++st2) {
    const int st = st2 >> 1;
    if ((st2 & 1) && !((REPEAT_MASK >> st) & 1)) continue;
    if (EXTRA_SYNCS && st2 == 2 * step_lo) { for (int i = 0; i < EXTRA_SYNCS; ++i) cg::this_grid().sync(); }
    KParams Pl = Pk; asm volatile("" : "+s"(Pl));
    bool sync_after = true;
    const int gi = Pl->step_gd[st];
    if (gi == -2) continue;
    if (gi >= 0) {
      if (EN(100 + 1) || EN(100 + 2) || EN(100 + 3)) {
      const __attribute__((address_space(4))) GD& d = Pl->gd[gi];
      Gemm g{d.A, d.Bt, d.M, d.N, d.K, d.lda, d.ldb, d.gate};
      StaticOrder S; S.init(g.M, g.N, (int)gridDim.x, (int)blockIdx.x);
      if (d.kind == 1) { if (EN(101)) { EpiBf e{(bf16_t*)d.p0, d.ld0, (bf16_t*)d.p1, d.ld1, d.split, d.mode, (const float*)d.q0, (const u64_t*)d.q1, __int_as_float(d.pad), (u64_t*)d.q2, (u64_t*)d.q3}; pg8::gemm_phase<EpiBf>(lds, g, S, e); } }
      else if (d.kind == 2) { if (EN(102)) { EpiRes e{(const float*)d.q0, (const bf16_t*)d.q2, (float*)d.p0, (bf16_t*)d.p1, (u64_t*)d.q1}; pg8::gemm_phase<EpiRes>(lds, g, S, e); } }
      else { if (EN(103)) { EpiGate e{(const bf16_t*)d.q0, (const float*)d.q1, (const float*)d.q2, (const float*)d.q3, (bf16_t*)d.p0, (bf16_t*)d.p1}; pg8::gemm_phase<EpiGate>(lds, g, S, e); } }
      }
      if (st == 1 && gridDim.x == 256 && blockIdx.x >= 128)
        convert_tiles(Pl, lds, CVT_TOTAL - CVT_DEFER + ((int)blockIdx.x - 128), 128, CVT_TOTAL);
      if (st == 3) sync_after = false;
    } else {
      KParams P = Pl;
      bf16_t* const X = P->X;
      bf16_t* const lat = X + (size_t)T_TOK * 3072;
      bf16_t* const ybuf = X; bf16_t* const xr = X + (size_t)T_TOK * DM; bf16_t* const labuf = xr + (size_t)T_TOK * DM; bf16_t* const bbuf = (bf16_t*)P->out;
      float* const asum = (float*)xr; float* const hend = asum + (size_t)NB * 128 * DM;
      const int layer = (st >= 10) ? 1 : 0;
      switch (st) {
        case 0: if (EN(0)) { phase_convert(P, lds); phase_rmsnorm(P->x, P->norm_mix, P->act, nullptr); } break;
        case 2: if (EN(2)) phase_prep(P, lat); break;
        case 5: if (EN(5)) phase_attention(P, lds); break;
        case 7: case 18: if (EN(7)) phase_rmsnorm(P->out, P->norm_mlp + layer * DM, P->act, nullptr); break;
        case 10: if (EN(7)) phase_rmsnorm(P->out, P->norm_mix + DM, P->act, nullptr); break;
        case 12: if (EN(12)) phase_conv(P, xr, P->act); break;
        case 14: if (EN(14)) phase_scan1(labuf, bbuf, asum, hend); break;
        case 15: if (EN(15)) phase_scan_carry(asum, hend); break;
        case 16: if (EN(16)) phase_scan2(labuf, bbuf, ybuf, hend, P->act); break;
        case 21: if (EN(7)) phase_rmsnorm(P->out, P->norm_final, nullptr, P->out); break;
        default: break;
      }
    }
    { const bool last_exec = (st + 1 >= step_hi) && ((st2 & 1) || !((REPEAT_MASK >> st) & 1));
      if (sync_after && !last_exec) { if (step_lo > 1000) cg::this_grid().sync(); else xcd_barrier(xb); } }
  }
}

extern "C" void kernel_launch(void* const* d_in, const int* in_sizes, int n_in, void* d_out, int out_size, void* d_ws, size_t ws_size, hipStream_t stream) {
  static int grid_blocks = 0;
  if (!grid_blocks) {
    hipFuncSetAttribute((const void*)fwd_kernel, hipFuncAttributeMaxDynamicSharedMemorySize, LDS_BYTES + 16);
    int dev = 0, cus = 0, per_cu = 0;
    hipGetDevice(&dev);
    hipDeviceGetAttribute(&cus, hipDeviceAttributeMultiprocessorCount, dev);
    hipOccupancyMaxActiveBlocksPerMultiprocessor(&per_cu, fwd_kernel, 512, LDS_BYTES);
    if (per_cu < 1) per_cu = 1;
    grid_blocks = cus;
  }
  Params p;
  memset(&p, 0, sizeof(p));
  p.x = (const float*)d_in[0]; p.pos = (const int*)d_in[1]; p.norm_mix = (const float*)d_in[2]; p.norm_mlp = (const float*)d_in[3]; p.norm_final = (const float*)d_in[4];
  p.w_in = (const float*)d_in[5]; p.lq1 = (const float*)d_in[6]; p.lk1 = (const float*)d_in[7]; p.lq2 = (const float*)d_in[8]; p.lk2 = (const float*)d_in[9]; p.subln = (const float*)d_in[10];
  p.q_norm = (const float*)d_in[11]; p.kv_norm = (const float*)d_in[12]; p.w_uq = (const float*)d_in[13]; p.w_ukv = (const float*)d_in[14]; p.w_out = (const float*)d_in[15];
  p.rw_in = (const float*)d_in[16]; p.conv_w = (const float*)d_in[17]; p.conv_b = (const float*)d_in[18]; p.w_a = (const float*)d_in[19]; p.b_a = (const float*)d_in[20]; p.w_x = (const float*)d_in[21]; p.b_x = (const float*)d_in[22];
  p.rlam = (const float*)d_in[23]; p.rw_out = (const float*)d_in[24]; p.w1 = (const float*)d_in[25]; p.w2 = (const float*)d_in[26];
  p.out = (float*)d_out;
  bf16_t* w = (bf16_t*)d_ws;
  p.Wt_in = w;  w += (size_t)4416 * 2048;
  p.Wt_uq = w;  w += (size_t)1536 * 768;
  p.Wt_ukv = w; w += (size_t)2048 * 512;
  p.Wt_out = w; w += (size_t)2048 * 2048;
  p.Wt_rin = w; w += (size_t)4096 * 2048;
  p.Wt_gate = w; w += (size_t)4096 * 256;
  p.Wt_rout = w; w += (size_t)2048 * 2048;
  p.Wt_w1 = w;  w += (size_t)2 * 8192 * 2048;
  p.Wt_w2 = w;  w += (size_t)2 * 8192 * 2048;
  p.act = w;    w += (size_t)T_TOK * DM;
  p.X = w;      w += (size_t)T_TOK * 8192;
  p.cs = (float*)w; w += (size_t)T_TOK * 32 * 2 * 2;
  p.sp8 = (float*)w; w += (size_t)DM * 2;
  p.bar = (unsigned*)w; w += (size_t)XCD_BAR_WORDS * 2;
  p.ssq = (u64_t*)w; w += (size_t)5 * T_TOK * 4;
  for (int i = 0; i < 32; ++i) p.inv_freq[i] = 1.0f / powf(10000.0f, (float)(2 * i) / 64.0f);
  {
    bf16_t* const X = p.X;
    bf16_t* const qkva = X; bf16_t* const lat = X + (size_t)T_TOK * 3072; bf16_t* const qbuf = lat + (size_t)T_TOK * 1536; bf16_t* const kvbuf = qbuf + (size_t)T_TOK * 1536;
    bf16_t* const ybuf = X; bf16_t* const xr = X + (size_t)T_TOK * DM; bf16_t* const labuf = xr + (size_t)T_TOK * DM; bf16_t* const bbuf = labuf + (size_t)T_TOK * DM;
    for (int i = 0; i < 24; ++i) p.step_gd[i] = -1;
    int n = 0;
    auto add = [&](int step, const bf16_t* A, const bf16_t* Bt, int M, int N, int K, int lda, int ldb, int gate, int kind, void* p0, void* p1, const void* q0, const void* q1, const void* q2, const void* q3, int ld0, int ld1, int split, int mode, float inv_n) {
      GD& d = p.gd[n]; d.A = A; d.Bt = Bt; d.p0 = p0; d.p1 = p1; d.q0 = q0; d.q1 = q1; d.q2 = q2; d.q3 = q3; d.M = M; d.N = N; d.K = K; d.lda = lda; d.ldb = ldb; d.gate = gate; d.kind = kind; d.ld0 = ld0; d.ld1 = ld1; d.split = split; d.mode = mode;
      { const float sc = inv_n / 1048576.f; memcpy(&d.pad, &sc, 4); }
      p.step_gd[step] = n++; };
    bf16_t* const HB = X + (size_t)T_TOK * 6144;
    bf16_t* const U = p.act;
    u64_t* const sq0 = p.ssq; u64_t* const sq1 = p.ssq + T_TOK; u64_t* const sq2 = p.ssq + 2 * T_TOK; u64_t* const sqq = p.ssq + 3 * T_TOK; u64_t* const sqkv = p.ssq + 4 * T_TOK;
    add(1, p.act, p.Wt_in, T_TOK, 4608, 2048, 2048, 2048, 0, 1, qkva, lat, p.cs, nullptr, sqq, sqkv, 3072, 1536, 12, 4, 0.f);
    p.step_gd[2] = -2;
    add(3, lat, p.Wt_uq, T_TOK, 1536, 768, 1536, 768, 0, 1, qbuf, qbuf, p.cs, sqq, nullptr, nullptr, 1536, 1536, 1000, 3, 1.f / 768.f);
    add(4, lat + 768, p.Wt_ukv, T_TOK, 2048, 512, 1536, 512, 0, 1, kvbuf, kvbuf, nullptr, sqkv, nullptr, nullptr, 2048, 2048, 1000, 0, 1.f / 512.f);
    add(6, p.act, p.Wt_out, T_TOK, 2048, 2048, 2048, 2048, 0, 2, nullptr, HB, p.x, sq0, nullptr, nullptr, 0, 0, 0, 0, 0.f);
    p.step_gd[7] = -2;
    add(8, HB, p.Wt_w1, T_TOK, 8192, 2048, 2048, 2048, 0, 1, U, U, nullptr, sq0, nullptr, nullptr, 8192, 8192, 1000, 1, 1.f / 2048.f);
    add(9, U, p.Wt_w2, T_TOK, 2048, 8192, 8192, 8192, 0, 2, nullptr, HB, nullptr, sq1, HB, nullptr, 0, 0, 0, 0, 0.f);
    p.step_gd[10] = -2;
    add(11, HB, p.Wt_rin, T_TOK, 4096, 2048, 2048, 2048, 0, 1, ybuf, xr, nullptr, sq1, nullptr, nullptr, 2048, 2048, 8, 2, 1.f / 2048.f);
    add(13, p.act, p.Wt_gate, T_TOK, 4096, 256, 2048, 256, 1, 3, labuf, (bf16_t*)p.out, p.act, p.b_a, p.b_x, p.sp8, 0, 0, 0, 0, 0.f);
    add(17, p.act, p.Wt_rout, T_TOK, 2048, 2048, 2048, 2048, 0, 2, nullptr, HB, nullptr, sq2, HB, nullptr, 0, 0, 0, 0, 0.f);
    p.step_gd[18] = -2;
    add(19, HB, p.Wt_w1 + (size_t)8192 * 2048, T_TOK, 8192, 2048, 2048, 2048, 0, 1, U, U, nullptr, sq2, nullptr, nullptr, 8192, 8192, 1000, 1, 1.f / 2048.f);
    add(20, U, p.Wt_w2 + (size_t)8192 * 2048, T_TOK, 2048, 8192, 8192, 8192, 0, 2, p.out, nullptr, nullptr, nullptr, HB, nullptr, 0, 0, 0, 0, 0.f);
  }
#if N_LAUNCH_MODE == 1
  p.step_lo = 0; p.step_hi = NSTEP;
  hipMemsetAsync(p.bar, 0, XCD_BAR_WORDS * 4, stream);
  void* args[] = {&p};
  hipError_t e = hipLaunchCooperativeKernel((const void*)fwd_kernel, dim3(grid_blocks), dim3(512), args, LDS_BYTES + 16, stream);
  if (e != hipSuccess) fprintf(stderr, "cooperative launch failed: %s (grid %d)\n", hipGetErrorString(e), grid_blocks);
#else
  for (int st = 0; st < NSTEP; ++st) {
    p.step_lo = st; p.step_hi = st + 1;
    hipLaunchKernelGGL(fwd_kernel, dim3(grid_blocks), dim3(512), LDS_BYTES + 16, stream, p);
  }
#endif
}
#ifdef TESTK
__global__ void __launch_bounds__(512, 2) tk1(Gemm g, EpiBf e) { extern __shared__ __attribute__((aligned(16))) unsigned char shm[]; StaticOrder S; S.init(g.M, g.N, (int)gridDim.x, (int)blockIdx.x); pg8::gemm_phase<EpiBf>((LAS unsigned char*)shm, g, S, e); }
__global__ void __launch_bounds__(512, 2) tk2(Gemm g, EpiRes e) { extern __shared__ __attribute__((aligned(16))) unsigned char shm[]; StaticOrder S; S.init(g.M, g.N, (int)gridDim.x, (int)blockIdx.x); pg8::gemm_phase<EpiRes>((LAS unsigned char*)shm, g, S, e); }
__global__ void __launch_bounds__(512, 2) tk3(Gemm g, EpiGate e) { extern __shared__ __attribute__((aligned(16))) unsigned char shm[]; StaticOrder S; S.init(g.M, g.N, (int)gridDim.x, (int)blockIdx.x); pg8::gemm_phase<EpiGate>((LAS unsigned char*)shm, g, S, e); }
#endif
```

```cpp
#include <hip/hip_runtime.h>
#include <hip/hip_cooperative_groups.h>
#include <cstdio>
#include <cmath>
#include <cstring>
namespace cg = cooperative_groups;

#ifndef N_LAUNCH_MODE
#define N_LAUNCH_MODE 1
#endif

#ifdef ONLY
#ifdef ONLY2
#define EN(n) ((n)==ONLY || (n)==ONLY2 || (n)==ONLY3)
#else
#define EN(n) ((n)==ONLY)
#endif
#else
#define EN(n) true
#endif
#define LAS __attribute__((address_space(3)))
#define DI __device__ __forceinline__
typedef unsigned short bf16_t;
typedef short bf16x8 __attribute__((ext_vector_type(8)));
typedef short s16x4 __attribute__((ext_vector_type(4)));
typedef float f32x2 __attribute__((ext_vector_type(2)));
typedef float f32x4 __attribute__((ext_vector_type(4)));
typedef float f32x16 __attribute__((ext_vector_type(16)));
typedef unsigned u32x2 __attribute__((ext_vector_type(2)));
typedef unsigned u32x4 __attribute__((ext_vector_type(4)));
typedef unsigned long long u64_t;


constexpr int T_TOK = 16384, SEQ = 4096, DM = 2048, NB = 4;
constexpr int LDS_BYTES = 131072;

struct GD { const bf16_t* A; const bf16_t* Bt; void* p0; void* p1; const void* q0; const void* q1; const void* q2; const void* q3; int M, N, K, lda, ldb, gate, kind, ld0, ld1, split, mode, pad; };
struct Params {
  const float* x; const int* pos; const float* norm_mix; const float* norm_mlp; const float* norm_final;
  const float* w_in; const float* lq1; const float* lk1; const float* lq2; const float* lk2; const float* subln;
  const float* q_norm; const float* kv_norm; const float* w_uq; const float* w_ukv; const float* w_out;
  const float* rw_in; const float* conv_w; const float* conv_b; const float* w_a; const float* b_a; const float* w_x; const float* b_x;
  const float* rlam; const float* rw_out; const float* w1; const float* w2;
  float* out;
  bf16_t *Wt_in, *Wt_uq, *Wt_ukv, *Wt_out, *Wt_rin, *Wt_gate, *Wt_rout, *Wt_w1, *Wt_w2;
  bf16_t* act; bf16_t* X; float* cs; float* sp8; unsigned* bar; u64_t* ssq;
  float inv_freq[32];
  int step_lo, step_hi;
  GD gd[11];
  int step_gd[24];
};
typedef const __attribute__((address_space(4))) Params* KParams;

DI unsigned cvt_pk_bf16(float lo, float hi) { unsigned r; asm volatile("v_cvt_pk_bf16_f32 %0, %1, %2" : "=v"(r) : "v"(lo), "v"(hi)); return r; }
DI float bf_lo(unsigned w) { return __uint_as_float(w << 16); }
DI float bf_hi(unsigned w) { return __uint_as_float(w & 0xffff0000u); }
DI float bf2f(bf16_t b) { return __uint_as_float(((unsigned)b) << 16); }
DI float wave_sum(float v) {
#pragma unroll
  for (int o = 32; o >= 1; o >>= 1) v += __shfl_xor(v, o);
  return v;
}

DI int tid_fresh() { int t = threadIdx.x; asm volatile("" : "+v"(t)); return t; }
namespace pg8 {
constexpr int BM = 256, BK = 64, HALF = 128, HTB = HALF * BK * 2, NXCD = 8, WGM = 4;
DI int lds_byte(int r, int c) { const int st = (r >> 4) * 2 + (c >> 5), rr = r & 15, cc = c & 31, ob = rr * 64 + cc * 2; return st * 1024 + (ob ^ (((ob >> 9) & 1) << 5)); }
DI void stage_rc(int b, int& R, int& C) { const int st = b / 1024, sb = b % 1024, swz = sb ^ (((sb >> 9) & 1) << 5); R = (st >> 1) * 16 + swz / 64; C = (st & 1) * 32 + (swz % 64) / 2; }
DI int perm32(int rho) { const int n = rho >> 4, i = rho & 15; return 8 * (i >> 2) + 4 * n + (i & 3); }

struct Unit { int pm, pn; };
struct Gemm { const bf16_t* A; const bf16_t* Bt; int M, N, K, lda, ldb, gate; };

struct StaticOrder {
  int nM, nN, nwg, G, c;
  DI void init(int M, int N, int G_, int c_) { nM = M / BM; nN = N / BM; nwg = nM * nN; G = G_; c = c_; }
  DI bool next(int i, Unit& u) const {
    const long L = (long)i * G + c; if (L >= nwg) return false;
    int wgid = (int)L; { const int q = nwg / NXCD, r = nwg % NXCD, xcd = wgid % NXCD, off = wgid / NXCD; wgid = (xcd < r ? xcd * (q + 1) : r * (q + 1) + (xcd - r) * q) + off; }
    const int nig = WGM * nN, gid = wgid / nig, fm = gid * WGM, gsz = (nM - fm) < WGM ? (nM - fm) : WGM;
    u.pm = fm + ((wgid % nig) % gsz); u.pn = (wgid % nig) / gsz; return true;
  }
};

template <class Epi>
DI void gemm_phase(LAS unsigned char* lds, const Gemm g, const StaticOrder& S, const Epi& E) {
  const int tid = tid_fresh(), wid = __builtin_amdgcn_readfirstlane(tid >> 6), lane = tid & 63, wr = wid >> 2, wc = wid & 3, fr = lane & 15, fq = lane >> 4;
  const int K = g.K, nt = K / BK;
  unsigned voffA[2], voffB[2];
#pragma unroll
  for (int i = 0; i < 2; ++i) { int R, C; stage_rc(tid * 16 + i * 8192, R, C); const int Rb = Epi::PERM ? ((R & ~31) + perm32(R & 31)) : R;
    voffA[i] = (unsigned)(R * g.lda + C) * 2u; voffB[i] = (unsigned)(Rb * g.ldb + C) * 2u; }
  const size_t kstep = (size_t)(BK * 2);
  const size_t hstepA = (size_t)HALF * g.lda * 2, hstepB = (size_t)HALF * g.ldb * 2;
  const unsigned ldsw = (unsigned)wid * 1024u;
  const int aoff = lds_byte(wr * 64 + fr, fq * 8), boff = lds_byte(wc * 32 + fr, fq * 8);
#define PG8_UA(u) ((const char*)g.A + ((size_t)(u).pm * 256 * g.lda + (g.gate ? (size_t)((u).pn >> 1) * 256 : 0)) * 2)
#define PG8_UB(u) ((const char*)g.Bt + ((size_t)(u).pn * 256 * g.ldb) * 2)
#define PG8_SA(b, h) (((b) * 2 + (h)) * HTB)
#define PG8_SB(b, h) ((4 + (b) * 2 + (h)) * HTB)
#define PG8_STAGE(bufoff, gbase, voff) do { _Pragma("unroll") for (int _i = 0; _i < 2; ++_i) \
    __builtin_amdgcn_global_load_lds((const unsigned*)((const char*)(gbase) + (voff)[_i]), (LAS unsigned*)(lds + (bufoff) + ldsw + _i * 8192), 16, 0, 0); } while (0)
#define PG8_LDA(dst, b, h) do { _Pragma("unroll") for (int m = 0; m < 4; ++m) _Pragma("unroll") for (int k = 0; k < 2; ++k) dst[m][k] = *(const LAS bf16x8*)(lds + PG8_SA(b, h) + aoff + m * 2048 + k * 1024); } while (0)
#define PG8_LDB(dst, b, h) do { _Pragma("unroll") for (int n = 0; n < 2; ++n) _Pragma("unroll") for (int k = 0; k < 2; ++k) dst[n][k] = *(const LAS bf16x8*)(lds + PG8_SB(b, h) + boff + n * 2048 + k * 1024); } while (0)
#define PG8_MMA(ai, bj, At, Bt) do { __builtin_amdgcn_s_setprio(1); _Pragma("unroll") for (int m = 0; m < 4; ++m) _Pragma("unroll") for (int n = 0; n < 2; ++n) _Pragma("unroll") for (int k = 0; k < 2; ++k) \
    acc[ai][bj][m][n] = __builtin_amdgcn_mfma_f32_16x16x32_bf16(Bt[n][k], At[m][k], acc[ai][bj][m][n], 0, 0, 0); __builtin_amdgcn_s_setprio(0); } while (0)
#define PG8_WAIT_V(n) asm volatile("s_waitcnt vmcnt(" #n ")" ::: "memory")
#define PG8_WAIT_L(n) asm volatile("s_waitcnt lgkmcnt(" #n ")" ::: "memory")
#define PG8_BAR __builtin_amdgcn_s_barrier()
#define PG8_SCHED __builtin_amdgcn_sched_barrier(0)
  Unit cur, nxt; int ui = 0;
  if (!S.next(0, cur)) return;
  f32x4 acc[2][2][4][2];
#pragma unroll
  for (int a = 0; a < 2; ++a)
#pragma unroll
    for (int b = 0; b < 2; ++b)
#pragma unroll
      for (int m = 0; m < 4; ++m)
#pragma unroll
        for (int n = 0; n < 2; ++n) acc[a][b][m][n] = (f32x4){0.f, 0.f, 0.f, 0.f};
  bf16x8 At[4][2], B0[2][2], B1[2][2];
  const char* cA = PG8_UA(cur); const char* cB = PG8_UB(cur);
  PG8_STAGE(PG8_SB(0, 0), cB, voffB); PG8_STAGE(PG8_SB(0, 1), cB + hstepB, voffB); PG8_STAGE(PG8_SA(0, 0), cA, voffA); PG8_STAGE(PG8_SA(0, 1), cA + hstepA, voffA);
  if (wr == 1) PG8_BAR;
  PG8_WAIT_V(2); PG8_BAR;
  PG8_STAGE(PG8_SB(1, 0), cB + kstep, voffB); PG8_STAGE(PG8_SA(1, 0), cA + kstep, voffA); PG8_STAGE(PG8_SB(1, 1), cB + hstepB + kstep, voffB);
  PG8_WAIT_V(6); PG8_BAR;
  for (;;) {
    const bool has_next = S.next(ui + 1, nxt);
    const char* nA = has_next ? PG8_UA(nxt) : cA; const char* nB = has_next ? PG8_UB(nxt) : cB;
    for (int t = 0; t < nt; t += 2) {
      const bool last = (t == nt - 2);
      const char* a1 = cA + (size_t)(t + 1) * kstep;
      const char* a2 = last ? nA : cA + (size_t)(t + 2) * kstep; const char* b2 = last ? nB : cB + (size_t)(t + 2) * kstep;
      const char* a3 = a2 + kstep; const char* b3 = b2 + kstep;
      PG8_LDB(B0, 0, 0); PG8_LDB(B1, 0, 1); PG8_SCHED; PG8_LDA(At, 0, 0); PG8_STAGE(PG8_SA(1, 1), a1 + hstepA, voffA);
      PG8_WAIT_V(8); PG8_WAIT_L(0); PG8_BAR; PG8_MMA(0, 0, At, B0); PG8_MMA(0, 1, At, B1); PG8_BAR; PG8_SCHED;
      PG8_LDA(At, 0, 1); PG8_STAGE(PG8_SB(0, 0), b2, voffB); PG8_STAGE(PG8_SB(0, 1), b2 + hstepB, voffB); PG8_STAGE(PG8_SA(0, 0), a2, voffA);
      PG8_WAIT_V(8); PG8_WAIT_L(0); PG8_BAR; PG8_MMA(1, 0, At, B0); PG8_MMA(1, 1, At, B1); PG8_BAR; PG8_SCHED;
      PG8_LDB(B0, 1, 0); PG8_LDB(B1, 1, 1); PG8_SCHED; PG8_LDA(At, 1, 0); PG8_STAGE(PG8_SA(0, 1), a2 + hstepA, voffA);
      PG8_WAIT_V(8); PG8_WAIT_L(0); PG8_BAR; PG8_MMA(0, 0, At, B0); PG8_MMA(0, 1, At, B1); PG8_BAR; PG8_SCHED;
      PG8_LDA(At, 1, 1); PG8_STAGE(PG8_SB(1, 0), b3, voffB); PG8_STAGE(PG8_SB(1, 1), b3 + hstepB, voffB); PG8_STAGE(PG8_SA(1, 0), a3, voffA);
      PG8_WAIT_V(8); PG8_WAIT_L(0); PG8_BAR; PG8_MMA(1, 0, At, B0); PG8_MMA(1, 1, At, B1); PG8_BAR; PG8_SCHED;
    }
    if (wr == 0) PG8_BAR;
    E(acc, cur, wr, wc, fr, fq);
    if (!has_next) break;
#pragma unroll
    for (int a = 0; a < 2; ++a)
#pragma unroll
      for (int b = 0; b < 2; ++b)
#pragma unroll
        for (int m = 0; m < 4; ++m)
#pragma unroll
          for (int n = 0; n < 2; ++n) acc[a][b][m][n] = (f32x4){0.f, 0.f, 0.f, 0.f};
    cur = nxt; cA = nA; cB = nB; ++ui;
    if (wr == 1) PG8_BAR;
  }
  PG8_WAIT_V(0);
  PG8_BAR;
#undef PG8_UA
#undef PG8_UB
#undef PG8_SA
#undef PG8_SB
#undef PG8_STAGE
#undef PG8_LDA
#undef PG8_LDB
#undef PG8_MMA
#undef PG8_WAIT_V
#undef PG8_WAIT_L
#undef PG8_BAR
#undef PG8_SCHED
}
}
using pg8::Unit; using pg8::Gemm; using pg8::StaticOrder;

struct EpiBf {
  static constexpr bool PERM = true;
  bf16_t* o0; int ld0; bf16_t* o1; int ld1; int split; int mode; const float* cs;
  const u64_t* ssq; float inv_n;
  u64_t* sqa; u64_t* sqb;
  DI void operator()(const f32x4 (&acc)[2][2][4][2], const Unit& u, int wr, int wc, int fr, int fq) const {
    const int row0 = u.pm * 256 + wr * 64 + fr;
    bf16_t* base; int ld, colt;
    if (u.pn < split) { base = o0; ld = ld0; colt = u.pn * 256; } else { base = o1; ld = ld1; colt = (u.pn - split) * 256; }
    const bool gelu = (mode == 2) && (u.pn < split);
    u64_t* sq = nullptr;
    if (mode == 4) { if (u.pn >= 12 && u.pn < 15) sq = sqa; else if (u.pn >= 15 && u.pn < 17) sq = sqb; }
    const bool krope = (mode == 4) && (u.pn == 17) && (wc < 2);
    float rsv[8];
#pragma unroll
    for (int i = 0; i < 8; ++i) rsv[i] = 1.f;
    if (ssq) {
#pragma unroll
      for (int i = 0; i < 8; ++i) rsv[i] = (float)ssq[row0 + (i >> 2) * 128 + (i & 3) * 16];
#pragma unroll
      for (int i = 0; i < 8; ++i) rsv[i] = rsqrtf(rsv[i] * inv_n + 1e-6f);
    }
#pragma unroll
    for (int ai = 0; ai < 2; ++ai)
#pragma unroll
      for (int m = 0; m < 4; ++m) {
        const int row = row0 + ai * 128 + m * 16;
        bf16_t* rowp = base + (size_t)row * ld + colt + wc * 32 + 8 * fq;
        const float rs = rsv[ai * 4 + m];
        if (sq) {
          float ss = 0.f;
#pragma unroll
          for (int bj = 0; bj < 2; ++bj)
#pragma unroll
            for (int n = 0; n < 2; ++n) { const f32x4 x = acc[ai][bj][m][n]; ss += x[0] * x[0] + x[1] * x[1] + x[2] * x[2] + x[3] * x[3]; }
          ss += __shfl_xor(ss, 16); ss += __shfl_xor(ss, 32);
          if (fq == 0) atomicAdd(sq + row, (u64_t)(ss * 1048576.f));
        }
#pragma unroll
        for (int bj = 0; bj < 2; ++bj) {
          f32x4 v0 = acc[ai][bj][m][0] * rs, v1 = acc[ai][bj][m][1] * rs;
          if (krope && bj == 0) {
            const float* c = cs + ((size_t)row * 32 + (wc * 32 + 8 * fq) / 2) * 2;
            const f32x4 cA = *(const f32x4*)c, cB = *(const f32x4*)(c + 4);
            f32x4 w0, w1;
            w0[0] = v0[0] * cA[0] - v0[1] * cA[1]; w0[1] = v0[1] * cA[0] + v0[0] * cA[1];
            w0[2] = v0[2] * cA[2] - v0[3] * cA[3]; w0[3] = v0[3] * cA[2] + v0[2] * cA[3];
            w1[0] = v1[0] * cB[0] - v1[1] * cB[1]; w1[1] = v1[1] * cB[0] + v1[0] * cB[1];
            w1[2] = v1[2] * cB[2] - v1[3] * cB[3]; w1[3] = v1[3] * cB[2] + v1[2] * cB[3];
            v0 = w0; v1 = w1;
          }
          if (mode == 1) {
#pragma unroll
            for (int j = 0; j < 4; ++j) { const float a = fmaxf(v0[j], 0.f), b = fmaxf(v1[j], 0.f); v0[j] = a * a; v1[j] = b * b; }
          }
          if (gelu) {
#pragma unroll
            for (int j = 0; j < 4; ++j) {
              { const float xx = v0[j]; const float z = 1.5957691216f * (xx + 0.044715f * xx * xx * xx); v0[j] = xx * __builtin_amdgcn_rcpf(1.f + __expf(-z)); }
              { const float xx = v1[j]; const float z = 1.5957691216f * (xx + 0.044715f * xx * xx * xx); v1[j] = xx * __builtin_amdgcn_rcpf(1.f + __expf(-z)); }
            }
          }
          if (mode == 3) {
            const int gc = u.pn * 256 + bj * 128 + wc * 32 + 8 * fq; const int ch = gc % 192;
            if (ch >= 128) {
              const float* c = cs + ((size_t)row * 32 + ((ch - 128) >> 1)) * 2;
              const f32x4 cA = *(const f32x4*)c, cB = *(const f32x4*)(c + 4);
              f32x4 w0, w1;
              w0[0] = v0[0] * cA[0] - v0[1] * cA[1]; w0[1] = v0[1] * cA[0] + v0[0] * cA[1];
              w0[2] = v0[2] * cA[2] - v0[3] * cA[3]; w0[3] = v0[3] * cA[2] + v0[2] * cA[3];
              w1[0] = v1[0] * cB[0] - v1[1] * cB[1]; w1[1] = v1[1] * cB[0] + v1[0] * cB[1];
              w1[2] = v1[2] * cB[2] - v1[3] * cB[3]; w1[3] = v1[3] * cB[2] + v1[2] * cB[3];
              v0 = w0; v1 = w1;
            }
          }
          u32x4 w; w.x = cvt_pk_bf16(v0[0], v0[1]); w.y = cvt_pk_bf16(v0[2], v0[3]); w.z = cvt_pk_bf16(v1[0], v1[1]); w.w = cvt_pk_bf16(v1[2], v1[3]);
          *(u32x4*)(rowp + bj * 128) = w;
        }
      }
  }
};
struct EpiRes {
  static constexpr bool PERM = false;
  const float* basef; const bf16_t* baseh; float* out; bf16_t* hb; u64_t* ssq;
  DI void operator()(const f32x4 (&acc)[2][2][4][2], const Unit& u, int wr, int wc, int fr, int fq) const {
    const int row0 = u.pm * 256 + wr * 64 + fr, col0 = u.pn * 256 + wc * 32 + 4 * fq;
    f32x4 cur[4], nxt[4];
    auto loadrow = [&](int row, f32x4 (&d)[4]) {
      const size_t off = (size_t)row * DM + col0;
      if (basef) {
#pragma unroll
        for (int q = 0; q < 4; ++q) d[q] = *(const f32x4*)(basef + off + (q >> 1) * 128 + (q & 1) * 16);
      } else {
#pragma unroll
        for (int q = 0; q < 4; ++q) { const u32x2 w = *(const u32x2*)(baseh + off + (q >> 1) * 128 + (q & 1) * 16); d[q] = (f32x4){bf_lo(w.x), bf_hi(w.x), bf_lo(w.y), bf_hi(w.y)}; }
      }
    };
    loadrow(row0, cur);
#pragma unroll
    for (int idx = 0; idx < 8; ++idx) {
      const int ai = idx >> 2, m = idx & 3;
      const int row = row0 + ai * 128 + m * 16;
      const size_t off = (size_t)row * DM + col0;
      if (idx + 1 < 8) loadrow(row0 + ((idx + 1) >> 2) * 128 + ((idx + 1) & 3) * 16, nxt);
      float ss = 0.f;
#pragma unroll
      for (int q = 0; q < 4; ++q) {
        const int bj = q >> 1, n = q & 1;
        const f32x4 o = cur[q] + acc[ai][bj][m][n];
        if (out) *(f32x4*)(out + off + bj * 128 + n * 16) = o;
        if (hb) { u32x2 w; w.x = cvt_pk_bf16(o[0], o[1]); w.y = cvt_pk_bf16(o[2], o[3]); *(u32x2*)(hb + off + bj * 128 + n * 16) = w; }
        if (ssq) ss += o[0] * o[0] + o[1] * o[1] + o[2] * o[2] + o[3] * o[3];
      }
      if (ssq) { ss += __shfl_xor(ss, 16); ss += __shfl_xor(ss, 32); if (fq == 0) atomicAdd(ssq + row, (u64_t)(ss * 1048576.f)); }
#pragma unroll
      for (int q = 0; q < 4; ++q) cur[q] = nxt[q];
    }
  }
};
struct EpiGate {
  static constexpr bool PERM = true;
  const bf16_t* xc; const float* ba; const float* bx; const float* sp8; bf16_t* la; bf16_t* bo;
  DI void operator()(const f32x4 (&acc)[2][2][4][2], const Unit& u, int wr, int wc, int fr, int fq) const {
    const int row0 = u.pm * 256 + wr * 64 + fr;
    const int ch0 = (u.pn >> 1) * 256 + (u.pn & 1) * 128 + wc * 32 + 8 * fq;
    float bav[8], bxv[8], spv[8];
    { const f32x4 a0 = *(const f32x4*)(ba + ch0), a1 = *(const f32x4*)(ba + ch0 + 4), x0 = *(const f32x4*)(bx + ch0), x1 = *(const f32x4*)(bx + ch0 + 4), s0 = *(const f32x4*)(sp8 + ch0), s1 = *(const f32x4*)(sp8 + ch0 + 4);
#pragma unroll
      for (int j = 0; j < 4; ++j) { bav[j] = a0[j]; bav[4 + j] = a1[j]; bxv[j] = x0[j]; bxv[4 + j] = x1[j]; spv[j] = s0[j]; spv[4 + j] = s1[j]; } }
    u32x4 xw = *(const u32x4*)(xc + (size_t)row0 * DM + ch0), xwn = xw;
#pragma unroll
    for (int idx = 0; idx < 8; ++idx) {
        const int ai = idx >> 2, m = idx & 3;
        const size_t off = (size_t)(row0 + ai * 128 + m * 16) * DM + ch0;
        if (idx + 1 < 8) xwn = *(const u32x4*)(xc + (size_t)(row0 + ((idx + 1) >> 2) * 128 + ((idx + 1) & 3) * 16) * DM + ch0);
        float xv[8]; xv[0] = bf_lo(xw.x); xv[1] = bf_hi(xw.x); xv[2] = bf_lo(xw.y); xv[3] = bf_hi(xw.y); xv[4] = bf_lo(xw.z); xv[5] = bf_hi(xw.z); xv[6] = bf_lo(xw.w); xv[7] = bf_hi(xw.w);
        float lav[8], bv[8];
#pragma unroll
        for (int n = 0; n < 2; ++n)
#pragma unroll
          for (int j = 0; j < 4; ++j) {
            const int e = 4 * n + j;
            const float r = __builtin_amdgcn_rcpf(1.f + __expf(-(acc[ai][0][m][n][j] + bav[e])));
            const float ig = __builtin_amdgcn_rcpf(1.f + __expf(-(acc[ai][1][m][n][j] + bxv[e])));
            const float l = -r * spv[e];
            const float x2 = 2.f * l;
            const float om = (x2 > -0.1f) ? -x2 * (1.f + x2 * (0.5f + x2 * (0.16666667f + x2 * 0.041666668f))) : 1.f - __expf(x2);
            lav[e] = l; bv[e] = sqrtf(om) * ig * xv[e];
          }
        u32x4 wl, wb;
        wl.x = cvt_pk_bf16(lav[0], lav[1]); wl.y = cvt_pk_bf16(lav[2], lav[3]); wl.z = cvt_pk_bf16(lav[4], lav[5]); wl.w = cvt_pk_bf16(lav[6], lav[7]);
        wb.x = cvt_pk_bf16(bv[0], bv[1]); wb.y = cvt_pk_bf16(bv[2], bv[3]); wb.z = cvt_pk_bf16(bv[4], bv[5]); wb.w = cvt_pk_bf16(bv[6], bv[7]);
        *(u32x4*)(la + off) = wl; *(u32x4*)(bo + off) = wb;
        xw = xwn;
      }
  }
};

struct CvtJob { const float* src; int ld_src; bf16_t* dst; int ld_dst; int perm; const float* gain; };
DI CvtJob cvt_decode(KParams P, int tile) {
  constexpr int NJ = 11;
  const int jK[NJ]  = {2048, 768, 512, 2048, 2048, 256, 2048, 2048, 8192, 2048, 8192};
  const int jNT[NJ] = {69, 24, 32, 32, 64, 64, 32, 128, 32, 128, 32};
  int j = 0, idx = tile;
#pragma unroll
  for (int jj = 0; jj < NJ - 1; ++jj) { const int cnt = (jK[jj] / 128) * jNT[jj]; if (j == jj && idx >= cnt) { idx -= cnt; j = jj + 1; } }
  int K = 2048;
  switch (j) { case 1: K = 768; break; case 2: K = 512; break; case 5: K = 256; break; case 8: case 10: K = 8192; break; default: break; }
  const int nkt = K / 128, kt = idx % nkt, ntile = idx / nkt, k0 = kt * 128, n0 = ntile * 64;
  const float* src; int ld_src; bf16_t* dst; int perm = 0; const float* gain = nullptr;
  switch (j) {
    case 0: src = P->w_in + (size_t)k0 * 4416 + n0; ld_src = 4416; dst = P->Wt_in; perm = (ntile == 68) ? 1 : 0; break;
    case 1: src = P->w_uq + (size_t)k0 * 1536 + n0; ld_src = 1536; dst = P->Wt_uq; perm = ((ntile % 3) == 2) ? 1 : 0; gain = P->q_norm + k0; break;
    case 2: src = P->w_ukv + (size_t)k0 * 2048 + n0; ld_src = 2048; dst = P->Wt_ukv; gain = P->kv_norm + k0; break;
    case 3: src = P->w_out + (size_t)k0 * 2048 + n0; ld_src = 2048; dst = P->Wt_out; break;
    case 4: src = P->rw_in + (size_t)k0 * 4096 + n0; ld_src = 4096; dst = P->Wt_rin; gain = P->norm_mix + DM + k0; break;
    case 5: { const int pn = n0 >> 8, rr = n0 & 255, blk = pn >> 1, half = pn & 1;
              src = (rr < 128 ? P->w_a : P->w_x) + (size_t)blk * 65536 + (size_t)k0 * 256 + half * 128 + (rr & 127); ld_src = 256; dst = P->Wt_gate; } break;
    case 6: src = P->rw_out + (size_t)k0 * 2048 + n0; ld_src = 2048; dst = P->Wt_rout; break;
    case 7: src = P->w1 + (size_t)2048 * 8192 + (size_t)k0 * 8192 + n0; ld_src = 8192; dst = P->Wt_w1 + (size_t)8192 * 2048; gain = P->norm_mlp + DM + k0; break;
    case 8: src = P->w2 + (size_t)8192 * 2048 + (size_t)k0 * 2048 + n0; ld_src = 2048; dst = P->Wt_w2 + (size_t)2048 * 8192; break;
    case 9: src = P->w1 + (size_t)k0 * 8192 + n0; ld_src = 8192; dst = P->Wt_w1; gain = P->norm_mlp + k0; break;
    default: src = P->w2 + (size_t)k0 * 2048 + n0; ld_src = 2048; dst = P->Wt_w2; break;
  }
  CvtJob jb; jb.src = src; jb.ld_src = ld_src; jb.dst = dst + (size_t)n0 * K + k0; jb.ld_dst = K; jb.perm = perm; jb.gain = gain; return jb;
}
constexpr int CVT_TOTAL = 16 * 69 + 6 * 24 + 4 * 32 + 16 * 32 + 16 * 64 + 2 * 64 + 16 * 32 + 16 * 128 + 16 * 128 + 64 * 32 + 64 * 32;
constexpr int CVT_DEFER = 3072;
DI void convert_tiles(KParams P, LAS unsigned char* lds, int first, int stride, int total) {
  const int tid = tid_fresh(), kr = tid >> 4, c4 = tid & 15;
  f32x4 cur[4], nxt[4];
  int tile = first;
  CvtJob jb;
  if (tile < total) { jb = cvt_decode(P, tile);
#pragma unroll
    for (int p = 0; p < 2; ++p) { const int k = 64 * p + 2 * kr; cur[2 * p] = __builtin_nontemporal_load((const f32x4*)(jb.src + (size_t)k * jb.ld_src + 4 * c4)); cur[2 * p + 1] = __builtin_nontemporal_load((const f32x4*)(jb.src + (size_t)(k + 1) * jb.ld_src + 4 * c4)); } }
  int buf = 0;
  for (; tile < total; tile += stride) {
    const int ntile = tile + stride;
    CvtJob nj = jb;
    if (ntile < total) { nj = cvt_decode(P, ntile);
#pragma unroll
      for (int p = 0; p < 2; ++p) { const int k = 64 * p + 2 * kr; nxt[2 * p] = __builtin_nontemporal_load((const f32x4*)(nj.src + (size_t)k * nj.ld_src + 4 * c4)); nxt[2 * p + 1] = __builtin_nontemporal_load((const f32x4*)(nj.src + (size_t)(k + 1) * nj.ld_src + 4 * c4)); } }
    LAS unsigned char* L = lds + buf * 16896;
#pragma unroll
    for (int p = 0; p < 2; ++p) {
      const int k = 64 * p + 2 * kr;
      float g0 = 1.f, g1 = 1.f;
      if (jb.gain) { g0 = jb.gain[k]; g1 = jb.gain[k + 1]; }
#pragma unroll
      for (int i = 0; i < 4; ++i) {
        const int sc = 4 * c4 + i; const int n = jb.perm ? ((sc < 32) ? 2 * sc : 2 * (sc - 32) + 1) : sc;
        *(LAS unsigned*)(L + n * 264 + k * 2) = cvt_pk_bf16(cur[2 * p][i] * g0, cur[2 * p + 1][i] * g1);
      }
    }
    __syncthreads();
#pragma unroll
    for (int i = 0; i < 4; ++i) {
      const int pc = tid + 512 * i, n = pc >> 5, kc = pc & 31;
      const u32x2 v = *(const LAS u32x2*)(L + n * 264 + kc * 8);
      *(u32x2*)(jb.dst + (size_t)n * jb.ld_dst + kc * 4) = v;
    }
    buf ^= 1; jb = nj;
#pragma unroll
    for (int i = 0; i < 4; ++i) cur[i] = nxt[i];
  }
  __syncthreads();
}
DI void phase_convert(KParams P, LAS unsigned char* lds) {
  convert_tiles(P, lds, blockIdx.x, gridDim.x, (gridDim.x == 256) ? CVT_TOTAL - CVT_DEFER : CVT_TOTAL);
  const int gtid = blockIdx.x * 512 + tid_fresh(), gsz = gridDim.x * 512;
  for (int i = gtid; i < T_TOK * 32; i += gsz) {
    const int t = i >> 5, f = i & 31;
    const float ang = (float)P->pos[t] * P->inv_freq[f];
    double rev = (double)ang * 0.15915494309189535; rev -= rint(rev);
    const float rf = (float)rev;
    P->cs[2 * i] = __builtin_amdgcn_cosf(rf); P->cs[2 * i + 1] = __builtin_amdgcn_sinf(rf);
  }
  for (int i = gtid; i < DM; i += gsz) P->sp8[i] = 8.f * log1pf(__expf(-P->rlam[i]));
  for (int i = gtid; i < 5 * T_TOK; i += gsz) P->ssq[i] = 0ull;
}

DI void phase_rmsnorm(const float* src, const float* g, bf16_t* dst, float* fout) {
  const int lane = tid_fresh() & 63, wid = tid_fresh() >> 6;
  f32x4 gv[8];
#pragma unroll
  for (int j = 0; j < 8; ++j) gv[j] = *(const f32x4*)(g + (j * 64 + lane) * 4);
  for (int row = blockIdx.x * 8 + wid; row < T_TOK; row += gridDim.x * 8) {
    const float* p = src + (size_t)row * DM;
    f32x4 v[8]; float ss = 0.f;
#pragma unroll
    for (int j = 0; j < 8; ++j) { v[j] = *(const f32x4*)(p + (j * 64 + lane) * 4); ss += v[j][0] * v[j][0] + v[j][1] * v[j][1] + v[j][2] * v[j][2] + v[j][3] * v[j][3]; }
    ss = wave_sum(ss);
    const float rs = rsqrtf(ss * (1.f / DM) + 1e-6f);
    if (fout) {
#pragma unroll
      for (int j = 0; j < 8; ++j) *(f32x4*)(fout + (size_t)row * DM + (j * 64 + lane) * 4) = v[j] * rs * gv[j];
    } else {
#pragma unroll
      for (int j = 0; j < 8; ++j) { const f32x4 o = v[j] * rs * gv[j]; u32x2 w; w.x = cvt_pk_bf16(o[0], o[1]); w.y = cvt_pk_bf16(o[2], o[3]); *(u32x2*)(dst + (size_t)row * DM + (j * 64 + lane) * 4) = w; }
    }
  }
}

DI void phase_prep(KParams P, bf16_t* lat) {
  const int lane = tid_fresh() & 63, wid = tid_fresh() >> 6;
  for (int row = blockIdx.x * 8 + wid; row < T_TOK; row += gridDim.x * 8) {
    bf16_t* p = lat + (size_t)row * 1536;
    u32x2 a[3], b[2]; float s1 = 0.f, s2 = 0.f;
#pragma unroll
    for (int j = 0; j < 3; ++j) { a[j] = *(const u32x2*)(p + (j * 64 + lane) * 4); const float x0 = bf_lo(a[j].x), x1 = bf_hi(a[j].x), x2 = bf_lo(a[j].y), x3 = bf_hi(a[j].y); s1 += x0 * x0 + x1 * x1 + x2 * x2 + x3 * x3; }
#pragma unroll
    for (int j = 0; j < 2; ++j) { b[j] = *(const u32x2*)(p + 768 + (j * 64 + lane) * 4); const float x0 = bf_lo(b[j].x), x1 = bf_hi(b[j].x), x2 = bf_lo(b[j].y), x3 = bf_hi(b[j].y); s2 += x0 * x0 + x1 * x1 + x2 * x2 + x3 * x3; }
    const float kr = bf2f(p[1280 + lane]);
    s1 = wave_sum(s1); s2 = wave_sum(s2);
    const float r1 = rsqrtf(s1 * (1.f / 768.f) + 1e-6f), r2 = rsqrtf(s2 * (1.f / 512.f) + 1e-6f);
#pragma unroll
    for (int j = 0; j < 3; ++j) { const f32x4 g = *(const f32x4*)(P->q_norm + (j * 64 + lane) * 4);
      u32x2 w; w.x = cvt_pk_bf16(bf_lo(a[j].x) * r1 * g[0], bf_hi(a[j].x) * r1 * g[1]); w.y = cvt_pk_bf16(bf_lo(a[j].y) * r1 * g[2], bf_hi(a[j].y) * r1 * g[3]); *(u32x2*)(p + (j * 64 + lane) * 4) = w; }
#pragma unroll
    for (int j = 0; j < 2; ++j) { const f32x4 g = *(const f32x4*)(P->kv_norm + (j * 64 + lane) * 4);
      u32x2 w; w.x = cvt_pk_bf16(bf_lo(b[j].x) * r2 * g[0], bf_hi(b[j].x) * r2 * g[1]); w.y = cvt_pk_bf16(bf_lo(b[j].y) * r2 * g[2], bf_hi(b[j].y) * r2 * g[3]); *(u32x2*)(p + 768 + (j * 64 + lane) * 4) = w; }
    const float other = __shfl_xor(kr, 32);
    const int i = lane & 31;
    const float c = P->cs[((size_t)row * 32 + i) * 2], s = P->cs[((size_t)row * 32 + i) * 2 + 1];
    const float o = (lane < 32) ? (kr * c - other * s) : (kr * c + other * s);
    p[1280 + 2 * i + (lane >> 5)] = (bf16_t)(cvt_pk_bf16(o, 0.f) & 0xffffu);
  }
}

DI void phase_conv(KParams P, const bf16_t* xr, bf16_t* xc) {
  for (int it = blockIdx.x * 512 + tid_fresh(); it < (T_TOK / 8) * 256; it += gridDim.x * 512) {
    const int chg = it & 255, tg = it >> 8, t0 = tg * 8, ch = chg * 8;
    float w[4][8], bias[8];
#pragma unroll
    for (int j = 0; j < 4; ++j) { const f32x4 a = *(const f32x4*)(P->conv_w + j * DM + ch), b = *(const f32x4*)(P->conv_w + j * DM + ch + 4);
#pragma unroll
      for (int e = 0; e < 4; ++e) { w[j][e] = a[e]; w[j][4 + e] = b[e]; } }
    { const f32x4 a = *(const f32x4*)(P->conv_b + ch), b = *(const f32x4*)(P->conv_b + ch + 4);
#pragma unroll
      for (int e = 0; e < 4; ++e) { bias[e] = a[e]; bias[4 + e] = b[e]; } }
    float win[3][8];
    const bool first = (t0 & (SEQ - 1)) == 0;
#pragma unroll
    for (int j = 0; j < 3; ++j) {
      u32x4 v = (u32x4){0u, 0u, 0u, 0u};
      if (!first) v = *(const u32x4*)(xr + (size_t)(t0 - 3 + j) * DM + ch);
      win[j][0] = bf_lo(v.x); win[j][1] = bf_hi(v.x); win[j][2] = bf_lo(v.y); win[j][3] = bf_hi(v.y); win[j][4] = bf_lo(v.z); win[j][5] = bf_hi(v.z); win[j][6] = bf_lo(v.w); win[j][7] = bf_hi(v.w);
    }
#pragma unroll
    for (int t = 0; t < 8; ++t) {
      const u32x4 v = *(const u32x4*)(xr + (size_t)(t0 + t) * DM + ch);
      float cur[8]; cur[0] = bf_lo(v.x); cur[1] = bf_hi(v.x); cur[2] = bf_lo(v.y); cur[3] = bf_hi(v.y); cur[4] = bf_lo(v.z); cur[5] = bf_hi(v.z); cur[6] = bf_lo(v.w); cur[7] = bf_hi(v.w);
      float o[8];
#pragma unroll
      for (int e = 0; e < 8; ++e) o[e] = bias[e] + w[0][e] * win[0][e] + w[1][e] * win[1][e] + w[2][e] * win[2][e] + w[3][e] * cur[e];
      u32x4 wv; wv.x = cvt_pk_bf16(o[0], o[1]); wv.y = cvt_pk_bf16(o[2], o[3]); wv.z = cvt_pk_bf16(o[4], o[5]); wv.w = cvt_pk_bf16(o[6], o[7]);
      *(u32x4*)(xc + (size_t)(t0 + t) * DM + ch) = wv;
#pragma unroll
      for (int e = 0; e < 8; ++e) { win[0][e] = win[1][e]; win[1][e] = win[2][e]; win[2][e] = cur[e]; }
    }
  }
}

DI void unpack8(const u32x4 v, float* f) { f[0] = bf_lo(v.x); f[1] = bf_hi(v.x); f[2] = bf_lo(v.y); f[3] = bf_hi(v.y); f[4] = bf_lo(v.z); f[5] = bf_hi(v.z); f[6] = bf_lo(v.w); f[7] = bf_hi(v.w); }
DI void phase_scan1(const bf16_t* la, const bf16_t* bb, float* asum, float* hend) {
  for (int it = blockIdx.x * 512 + tid_fresh(); it < NB * 128 * 256; it += gridDim.x * 512) {
    const int chg = it & 255, c = (it >> 8) & 127, b = it >> 15;
    const size_t base = ((size_t)b * SEQ + c * 32) * DM + chg * 8;
    float h[8], as[8];
#pragma unroll
    for (int e = 0; e < 8; ++e) { h[e] = 0.f; as[e] = 0.f; }
#pragma unroll 8
    for (int t = 0; t < 32; ++t) {
      float l[8], bv[8]; unpack8(*(const u32x4*)(la + base + (size_t)t * DM), l); unpack8(*(const u32x4*)(bb + base + (size_t)t * DM), bv);
#pragma unroll
      for (int e = 0; e < 8; ++e) { h[e] = __expf(l[e]) * h[e] + bv[e]; as[e] += l[e]; }
    }
    const size_t so = ((size_t)b * 128 + c) * DM + chg * 8;
    *(f32x4*)(asum + so) = (f32x4){as[0], as[1], as[2], as[3]}; *(f32x4*)(asum + so + 4) = (f32x4){as[4], as[5], as[6], as[7]};
    *(f32x4*)(hend + so) = (f32x4){h[0], h[1], h[2], h[3]}; *(f32x4*)(hend + so + 4) = (f32x4){h[4], h[5], h[6], h[7]};
  }
}
DI void phase_scan_carry(const float* asum, float* hend) {
  for (int it = blockIdx.x * 512 + tid_fresh(); it < NB * DM; it += gridDim.x * 512) {
    const int ch = it & (DM - 1), b = it >> 11;
    float H = 0.f;
    for (int c0 = 0; c0 < 128; c0 += 16) {
      float a[16], he[16];
#pragma unroll
      for (int i = 0; i < 16; ++i) { const size_t o = ((size_t)b * 128 + c0 + i) * DM + ch; a[i] = asum[o]; he[i] = hend[o]; }
#pragma unroll
      for (int i = 0; i < 16; ++i) { const size_t o = ((size_t)b * 128 + c0 + i) * DM + ch; hend[o] = H; H = __expf(a[i]) * H + he[i]; }
    }
  }
}
DI void phase_scan2(const bf16_t* la, const bf16_t* bb, const bf16_t* y, const float* hin, bf16_t* yh) {
  for (int it = blockIdx.x * 512 + tid_fresh(); it < NB * 128 * 256; it += gridDim.x * 512) {
    const int chg = it & 255, c = (it >> 8) & 127, b = it >> 15;
    const size_t base = ((size_t)b * SEQ + c * 32) * DM + chg * 8;
    const size_t so = ((size_t)b * 128 + c) * DM + chg * 8;
    float h[8];
    { const f32x4 a = *(const f32x4*)(hin + so), bq = *(const f32x4*)(hin + so + 4);
#pragma unroll
      for (int e = 0; e < 4; ++e) { h[e] = a[e]; h[4 + e] = bq[e]; } }
#pragma unroll 8
    for (int t = 0; t < 32; ++t) {
      float l[8], bv[8], yv[8]; unpack8(*(const u32x4*)(la + base + (size_t)t * DM), l); unpack8(*(const u32x4*)(bb + base + (size_t)t * DM), bv); unpack8(*(const u32x4*)(y + base + (size_t)t * DM), yv);
      float o[8];
#pragma unroll
      for (int e = 0; e < 8; ++e) { h[e] = __expf(l[e]) * h[e] + bv[e]; o[e] = h[e] * yv[e]; }
      u32x4 wv; wv.x = cvt_pk_bf16(o[0], o[1]); wv.y = cvt_pk_bf16(o[2], o[3]); wv.z = cvt_pk_bf16(o[4], o[5]); wv.w = cvt_pk_bf16(o[6], o[7]);
      *(u32x4*)(yh + base + (size_t)t * DM) = wv;
    }
  }
}

DI void glds16(const void* gsrc, unsigned lds_dst) { unsigned keep;
  asm volatile("s_mov_b32 %0, m0\n\ts_mov_b32 m0, %2\n\ts_nop 0\n\tglobal_load_lds_dwordx4 %1, off\n\ts_mov_b32 m0, %0" : "=&s"(keep) : "v"(gsrc), "s"(lds_dst) : "memory"); }
DI float max3f(float a, float b, float c) { float r; asm("v_max3_f32 %0, %1, %2, %3" : "=v"(r) : "v"(a), "v"(b), "v"(c)); return r; }
struct AttnSrc {
  const bf16_t* q; int ldq;
  const bf16_t* k0; int ldk0; int nk0;
  const bf16_t* k1; int ldk1;
  const bf16_t* v; int ldv;
};
template <int DK>
DI void attn_pass(const AttnSrc& s, const int q0, const float sc, LAS unsigned char* lds, f32x16 (&O)[4]) {
  constexpr int ROWB = DK * 2, KSZ = 64 * ROWB, VSZ = 16384, KP = KSZ / 8192, NS = DK / 16, STG = KSZ + VSZ, NBUF = (DK == 64) ? 4 : 3, DPF = NBUF - 1, PT = KP + 2;
  const int tid = tid_fresh(), lane = tid & 63, wid = __builtin_amdgcn_readfirstlane(tid >> 6), r = lane & 31, h = lane >> 5;
  const int qw0 = q0 + wid * 32;
  asm volatile("s_waitcnt vmcnt(0)" ::: "memory");
#pragma unroll
  for (int i = 0; i < 4; ++i)
#pragma unroll
    for (int j = 0; j < 16; ++j) O[i][j] = 0.f;
  float mrun = (DK == 64) ? 0.f : -INFINITY, lrun = 0.f;
  const int NT = (q0 + 256) / 64;
  const bf16_t* kp[KP]; int kstr[KP]; const bf16_t* vp[2];
#pragma unroll
  for (int i = 0; i < KP; ++i) {
    const int o = (wid + 8 * i) * 1024 + lane * 16, row = o / ROWB, pc = (o % ROWB) >> 4;
    const int lc = (DK == 64) ? (pc ^ (row & 7)) : ((pc & ~7) | ((pc & 7) ^ ((row >> 1) & 7)));
    const int e = lc * 8;
    if (e < s.nk0) { kp[i] = s.k0 + (size_t)row * s.ldk0 + e; kstr[i] = 64 * s.ldk0; } else { kp[i] = s.k1 + (size_t)row * s.ldk1 + (e - s.nk0); kstr[i] = 64 * s.ldk1; }
  }
#pragma unroll
  for (int i = 0; i < 2; ++i) {
    const int o = (wid + 8 * i) * 1024 + lane * 16, row = o >> 8, pc = (o >> 4) & 15;
    const int lc = (((pc >> 2) ^ (row & 3)) << 2) | (pc & 3);
    vp[i] = s.v + (size_t)row * s.ldv + lc * 8;
  }
  const int vstr = 64 * s.ldv;
  const unsigned lds0 = (unsigned)reinterpret_cast<__UINTPTR_TYPE__>(lds);
  auto issue = [&](int t, int buf) {
#pragma unroll
    for (int i = 0; i < KP; ++i) glds16(kp[i] + (size_t)t * kstr[i], (unsigned)__builtin_amdgcn_readfirstlane(lds0 + buf * STG + (wid + 8 * i) * 1024));
#pragma unroll
    for (int i = 0; i < 2; ++i) glds16(vp[i] + (size_t)t * vstr, (unsigned)__builtin_amdgcn_readfirstlane(lds0 + buf * STG + KSZ + (wid + 8 * i) * 1024));
  };
#pragma unroll
  for (int i = 0; i < DPF; ++i) issue(i, i);
  bf16x8 qf[NS];
#pragma unroll
  for (int i = 0; i < NS; ++i) qf[i] = *(const bf16x8*)(s.q + (size_t)(qw0 + r) * s.ldq + 16 * i + 8 * h);
#pragma unroll
  for (int i = 0; i < NS; ++i) asm volatile("" : "+v"(qf[i]));
  constexpr bool REL = (DK == 64);
  if (REL) {
#pragma unroll
  for (int i = 0; i < NS; ++i) {
    const u32x4 w = __builtin_bit_cast(u32x4, qf[i]); u32x4 o;
    o.x = cvt_pk_bf16(bf_lo(w.x) * sc, bf_hi(w.x) * sc); o.y = cvt_pk_bf16(bf_lo(w.y) * sc, bf_hi(w.y) * sc);
    o.z = cvt_pk_bf16(bf_lo(w.z) * sc, bf_hi(w.z) * sc); o.w = cvt_pk_bf16(bf_lo(w.w) * sc, bf_hi(w.w) * sc);
    qf[i] = __builtin_bit_cast(bf16x8, o);
  }
  }
  f32x16 negm;
#pragma unroll
  for (int j = 0; j < 16; ++j) negm[j] = 0.f;
  if (REL) asm volatile("" : "+v"(negm));
  const int kx = (DK == 64) ? (r & 7) : ((r >> 1) & 7);
  const int krow = r * ROWB;
  const int i15 = lane & 15;
  const int vrow = (4 * h + (i15 >> 2)) * 256 + ((lane >> 4) & 1) * 32 + (lane & 3) * 8;
  const int vx = (i15 >> 2) & 3;
  int buf = 0, pbuf = DPF;
  for (int t = 0; t < NT; ++t) {
    { const int rem = NT - 1 - t;
      if (rem >= DPF - 1) asm volatile("s_waitcnt vmcnt(%0)" :: "n"((DPF - 1) * PT) : "memory");
      else if (rem == 1) asm volatile("s_waitcnt vmcnt(%0)" :: "n"(PT) : "memory");
      else asm volatile("s_waitcnt vmcnt(0)" ::: "memory"); }
    __builtin_amdgcn_s_barrier();
    asm volatile("" ::: "memory");
    if (t + DPF < NT) issue(t + DPF, pbuf);
    if (64 * t <= qw0 + 31) {
      LAS unsigned char* Kb = lds + buf * STG; LAS unsigned char* Vb = lds + buf * STG + KSZ;
      f32x16 p0, p1;
      constexpr int GS = (DK == 64) ? 4 : 2, NG = NS / GS;
      bf16x8 kfa[2][GS], kfb[2][GS];
      auto kload = [&](int g, int slot) {
#pragma unroll
        for (int j = 0; j < GS; ++j) { const int lc = 2 * (g * GS + j) + h; const int ph = (DK == 64) ? (lc ^ kx) : ((lc & ~7) | ((lc & 7) ^ kx));
          kfa[slot][j] = *(const LAS bf16x8*)(Kb + krow + ph * 16); kfb[slot][j] = *(const LAS bf16x8*)(Kb + krow + 32 * ROWB + ph * 16); }
      };
      kload(0, 0);
#pragma unroll
      for (int g = 0; g < NG; ++g) {
        if (g + 1 < NG) kload(g + 1, (g + 1) & 1);
        __builtin_amdgcn_s_setprio(1);
#pragma unroll
        for (int j = 0; j < GS; ++j) {
          if (g == 0 && j == 0) {
            if (REL) {
              p0 = __builtin_amdgcn_mfma_f32_32x32x16_bf16(kfa[0][0], qf[0], negm, 0, 0, 0);
              p1 = __builtin_amdgcn_mfma_f32_32x32x16_bf16(kfb[0][0], qf[0], negm, 0, 0, 0);
            } else {
              f32x16 z;
#pragma unroll
              for (int jj = 0; jj < 16; ++jj) z[jj] = 0.f;
              p0 = __builtin_amdgcn_mfma_f32_32x32x16_bf16(kfa[0][0], qf[0], z, 0, 0, 0);
              p1 = __builtin_amdgcn_mfma_f32_32x32x16_bf16(kfb[0][0], qf[0], z, 0, 0, 0);
            }
          } else {
            p0 = __builtin_amdgcn_mfma_f32_32x32x16_bf16(kfa[g & 1][j], qf[g * GS + j], p0, 0, 0, 0);
            p1 = __builtin_amdgcn_mfma_f32_32x32x16_bf16(kfb[g & 1][j], qf[g * GS + j], p1, 0, 0, 0);
          }
        }
        __builtin_amdgcn_s_setprio(0);
      }
      bf16x8 vf[2][4];
      auto vload = [&](int vt, int slot) {
        const int vcol = vrow + ((vt ^ vx) << 6);
#pragma unroll
        for (int ks = 0; ks < 4; ++ks) {
          const s16x4 lo = __builtin_bit_cast(s16x4, __builtin_amdgcn_ds_read_tr16_b64_v4i16((LAS s16x4*)(Vb + vcol + ks * 16 * 256)));
          const s16x4 hi = __builtin_bit_cast(s16x4, __builtin_amdgcn_ds_read_tr16_b64_v4i16((LAS s16x4*)(Vb + vcol + (ks * 16 + 8) * 256)));
          vf[slot][ks] = __builtin_shufflevector(lo, hi, 0, 1, 2, 3, 4, 5, 6, 7);
        }
      };
      vload(0, 0);
      if (64 * t + 63 > qw0) {
        const int qa = qw0 + r, kbase = 64 * t + 4 * h;
#pragma unroll
        for (int j = 0; j < 16; ++j) { const int kv = kbase + (j & 3) + 8 * (j >> 2); if (kv > qa) p0[j] = -INFINITY; if (kv + 32 > qa) p1[j] = -INFINITY; }
      }
      asm volatile("s_nop 15\n\ts_nop 7" : "+v"(p0), "+v"(p1));
      float mx;
      { float ma = max3f(p0[0], p0[1], p1[0]), mb = max3f(p0[2], p0[3], p1[1]); ma = max3f(ma, p1[2], p1[3]);
#pragma unroll
        for (int j = 4; j < 16; j += 4) { ma = max3f(ma, p0[j], p0[j + 1]); mb = max3f(mb, p0[j + 2], p0[j + 3]); ma = max3f(ma, p1[j], p1[j + 1]); mb = max3f(mb, p1[j + 2], p1[j + 3]); }
        mx = fmaxf(ma, mb); }
      { auto rr = __builtin_amdgcn_permlane32_swap(__float_as_uint(mx), __float_as_uint(mx), false, false); mx = fmaxf(__uint_as_float(rr[0]), __uint_as_float(rr[1])); }
      float rs = 0.f;
      if (REL) {
        const bool grow = (mx > 8.f) || (t == 0);
        if (__builtin_amdgcn_ballot_w64(grow) != 0ull) {
          const float dl = grow ? mx : 0.f;
          const float alpha = __builtin_amdgcn_exp2f(-dl);
          mrun += dl; lrun *= alpha;
#pragma unroll
          for (int j = 0; j < 16; ++j) { p0[j] -= dl; p1[j] -= dl; negm[j] = -mrun; }
          asm volatile("" : "+v"(negm));
#pragma unroll
          for (int i = 0; i < 4; ++i)
#pragma unroll
            for (int j = 0; j < 16; ++j) O[i][j] *= alpha;
        }
#pragma unroll
        for (int j = 0; j < 16; ++j) { p0[j] = __builtin_amdgcn_exp2f(p0[j]); p1[j] = __builtin_amdgcn_exp2f(p1[j]); rs += p0[j] + p1[j]; }
      } else {
        const float cand = mx * sc;
        const bool grow = cand > mrun + 8.f;
        if (__builtin_amdgcn_ballot_w64(grow) != 0ull) {
          const float mnew = grow ? cand : mrun;
          const float alpha = __builtin_amdgcn_exp2f(mrun - mnew);
          mrun = mnew; lrun *= alpha;
#pragma unroll
          for (int i = 0; i < 4; ++i)
#pragma unroll
            for (int j = 0; j < 16; ++j) O[i][j] *= alpha;
        }
#pragma unroll
        for (int j = 0; j < 16; ++j) { p0[j] = __builtin_amdgcn_exp2f(p0[j] * sc - mrun); p1[j] = __builtin_amdgcn_exp2f(p1[j] * sc - mrun); rs += p0[j] + p1[j]; }
      }
      lrun += rs;
      bf16x8 pb[4];
      { u32x4 w;
        w.x = cvt_pk_bf16(p0[0], p0[1]); w.y = cvt_pk_bf16(p0[2], p0[3]); w.z = cvt_pk_bf16(p0[4], p0[5]); w.w = cvt_pk_bf16(p0[6], p0[7]); pb[0] = __builtin_bit_cast(bf16x8, w);
        w.x = cvt_pk_bf16(p0[8], p0[9]); w.y = cvt_pk_bf16(p0[10], p0[11]); w.z = cvt_pk_bf16(p0[12], p0[13]); w.w = cvt_pk_bf16(p0[14], p0[15]); pb[1] = __builtin_bit_cast(bf16x8, w);
        w.x = cvt_pk_bf16(p1[0], p1[1]); w.y = cvt_pk_bf16(p1[2], p1[3]); w.z = cvt_pk_bf16(p1[4], p1[5]); w.w = cvt_pk_bf16(p1[6], p1[7]); pb[2] = __builtin_bit_cast(bf16x8, w);
        w.x = cvt_pk_bf16(p1[8], p1[9]); w.y = cvt_pk_bf16(p1[10], p1[11]); w.z = cvt_pk_bf16(p1[12], p1[13]); w.w = cvt_pk_bf16(p1[14], p1[15]); pb[3] = __builtin_bit_cast(bf16x8, w); }
#pragma unroll
      for (int vt = 0; vt < 4; ++vt) {
        if (vt + 1 < 4) vload(vt + 1, (vt + 1) & 1);
        __builtin_amdgcn_s_setprio(1);
#pragma unroll
        for (int ks = 0; ks < 4; ++ks) O[vt] = __builtin_amdgcn_mfma_f32_32x32x16_bf16(vf[vt & 1][ks], pb[ks], O[vt], 0, 0, 0);
        __builtin_amdgcn_s_setprio(0);
      }
    }
    buf = (buf + 1 == NBUF) ? 0 : buf + 1; pbuf = (pbuf + 1 == NBUF) ? 0 : pbuf + 1;
  }
  asm volatile("s_waitcnt lgkmcnt(0)" ::: "memory");
  __builtin_amdgcn_s_barrier();
  asm volatile("" ::: "memory");
  float lt; { auto rr = __builtin_amdgcn_permlane32_swap(__float_as_uint(lrun), __float_as_uint(lrun), false, false); lt = __uint_as_float(rr[0]) + __uint_as_float(rr[1]); }
  const float inv = 1.f / lt;
#pragma unroll
  for (int i = 0; i < 4; ++i)
#pragma unroll
    for (int j = 0; j < 16; ++j) O[i][j] *= inv;
}

DI void attn_store(const f32x16 (&O)[4], bf16_t* dst, int qrow, int h) {
#pragma unroll
  for (int vt = 0; vt < 4; ++vt)
#pragma unroll
    for (int g = 0; g < 4; ++g) {
      u32x2 w; w.x = cvt_pk_bf16(O[vt][4 * g], O[vt][4 * g + 1]); w.y = cvt_pk_bf16(O[vt][4 * g + 2], O[vt][4 * g + 3]);
      *(u32x2*)(dst + (size_t)qrow * DM + 32 * vt + 8 * g + 4 * h) = w;
    }
}

DI void phase_attention(KParams P, LAS unsigned char* lds) {
  const bf16_t* qkva = P->X; const bf16_t* lat = P->X + (size_t)T_TOK * 3072; const bf16_t* qb_ = lat + (size_t)T_TOK * 1536; const bf16_t* kv = qb_ + (size_t)T_TOK * 1536;
  const int lane = tid_fresh() & 63, wid = tid_fresh() >> 6, r = lane & 31, h = lane >> 5;
  float lam;
  { const float s1 = wave_sum(P->lq1[lane] * P->lk1[lane]), s2 = wave_sum(P->lq2[lane] * P->lk2[lane]); lam = __expf(s1) - __expf(s2) + 0.2f; }
  const int G = gridDim.x;
  const int vb = ((int)blockIdx.x % 8) * (G / 8) + (int)blockIdx.x / 8;
  const float LOG2E = 1.4426950408889634f;
#ifndef ATTN_NO_A
  for (int it = vb; it < 256; it += G) {
    const int bh = it >> 3, sidx = it & 7, b = bh >> 3, head = bh & 7;
#pragma unroll 1
    for (int half = 0; half < 2; ++half) {
      const int qb = half ? 15 - sidx : sidx, q0 = qb * 256;
      const size_t rb = (size_t)b * SEQ;
      unsigned o1p[4][8];
      f32x16 O[4];
#pragma unroll 1
      for (int map = 0; map < 2; ++map) {
        AttnSrc s;
        s.q = qkva + rb * 3072 + head * 128 + map * 64; s.ldq = 3072;
        s.k0 = qkva + rb * 3072 + 1024 + head * 128 + map * 64; s.ldk0 = 3072; s.nk0 = 64; s.k1 = s.k0; s.ldk1 = 3072;
        s.v = qkva + rb * 3072 + 2048 + head * 128; s.ldv = 3072;
        attn_pass<64>(s, q0, 0.125f * LOG2E, lds, O);
        if (map == 0) {
#pragma unroll
          for (int i = 0; i < 4; ++i)
#pragma unroll
            for (int j = 0; j < 8; ++j) o1p[i][j] = cvt_pk_bf16(O[i][2 * j], O[i][2 * j + 1]);
        }
      }
      float ss = 0.f;
#pragma unroll
      for (int i = 0; i < 4; ++i)
#pragma unroll
        for (int j = 0; j < 8; ++j) { const float a = bf_lo(o1p[i][j]) - lam * O[i][2 * j], c = bf_hi(o1p[i][j]) - lam * O[i][2 * j + 1]; O[i][2 * j] = a; O[i][2 * j + 1] = c; ss += a * a + c * c; }
      ss += __shfl_xor(ss, 32);
      const float rs = rsqrtf(ss * (1.f / 128.f) + 1e-5f) * 0.8f;
#pragma unroll
      for (int i = 0; i < 4; ++i)
#pragma unroll
        for (int g = 0; g < 4; ++g) { const f32x4 gn = *(const f32x4*)(P->subln + 32 * i + 8 * g + 4 * h);
#pragma unroll
          for (int e = 0; e < 4; ++e) O[i][4 * g + e] *= rs * gn[e]; }
      attn_store(O, P->act + rb * DM + head * 128, q0 + wid * 32 + r, h);
    }
  }
#endif
#ifndef ATTN_NO_B
  for (int it = vb; it < 256; it += G) {
    const int bh = it >> 3, sidx = it & 7, b = bh >> 3, head = bh & 7;
#pragma unroll 1
    for (int half = 0; half < 2; ++half) {
      const int qb = half ? 15 - sidx : sidx, q0 = qb * 256;
      const size_t rb = (size_t)b * SEQ;
      f32x16 O[4];
      AttnSrc s;
      s.q = qb_ + rb * 1536 + head * 192; s.ldq = 1536;
      s.k0 = kv + rb * 2048 + head * 256; s.ldk0 = 2048; s.nk0 = 128; s.k1 = lat + rb * 1536 + 1280; s.ldk1 = 1536;
      s.v = kv + rb * 2048 + head * 256 + 128; s.ldv = 2048;
      attn_pass<192>(s, q0, 0.07216878364870322f * LOG2E, lds, O);
      attn_store(O, P->act + rb * DM + 1024 + head * 128, q0 + wid * 32 + r, h);
    }
  }
#endif
}

#define XB_TMO      128
#define XB_XCNT(j)  (256  + 64 * (j))
#define XB_XSUB(j)  (1280 + 64 * (j))
#define XB_XGEN(j)  (2304 + 64 * (j))
#define XB_TOP      3328
#define XB_TOPGEN   3392
#define XCD_BAR_WORDS 3456
#define XB_SPIN_CAP (1u << 18)

__device__ __forceinline__ unsigned xb_ld(unsigned* p)              { return __hip_atomic_load(p, __ATOMIC_RELAXED, __HIP_MEMORY_SCOPE_AGENT); }
__device__ __forceinline__ unsigned xb_add(unsigned* p, unsigned v) { return __hip_atomic_fetch_add(p, v, __ATOMIC_RELAXED, __HIP_MEMORY_SCOPE_AGENT); }
__device__ __forceinline__ unsigned xb_xcc_id() { return (unsigned)__builtin_amdgcn_s_getreg((3 << 11) | 20) & 0xFu; }
#define XB_SPIN(cond, bar) do { unsigned _sp = 0; while (cond) { __builtin_amdgcn_s_sleep(1); \
    if ((++_sp & 255u) == 0u) { if (xb_ld(&(bar)[XB_TMO])) break; if (_sp > XB_SPIN_CAP) { atomicAdd(&(bar)[XB_TMO], 1u); break; } } } } while (0)

struct XcdBarrier {
    unsigned* bar; unsigned x;
    volatile LAS unsigned* st;
};

__device__ __forceinline__ XcdBarrier xcd_barrier_post(unsigned* bar, volatile LAS unsigned* st) {
    XcdBarrier b; b.bar = bar; b.x = xb_xcc_id(); b.st = st;
    if (threadIdx.x == 0) (void)xb_add(&bar[XB_XCNT(b.x)], 1u);
    return b;
}
__device__ __forceinline__ void xcd_barrier_complete(unsigned* bar, unsigned x, unsigned& nloc, unsigned& nx) {
    const unsigned G = gridDim.x * gridDim.y * gridDim.z;
    unsigned sum, cnt, mine, sp = 0u;
    for (;;) {
        sum = 0u; cnt = 0u; mine = 0u;
#pragma unroll
        for (unsigned j = 0; j < 16; ++j) { const unsigned c = xb_ld(&bar[XB_XCNT(j)]); sum += c; cnt += (c > 0u) ? 1u : 0u; mine = (j == x) ? c : mine; }
        if (sum == G) break;
        __builtin_amdgcn_s_sleep(1);
        if ((++sp & 255u) == 0u) { if (xb_ld(&bar[XB_TMO])) break; if (sp > XB_SPIN_CAP) { atomicAdd(&bar[XB_TMO], 1u); break; } }
    }
    nloc = mine > 0u ? mine : 1u; nx = cnt > 0u ? cnt : 1u;
}

__device__ __forceinline__ void xcd_barrier(const XcdBarrier& b) {
    asm volatile("s_waitcnt vmcnt(0)" ::: "memory");
    __syncthreads();
    if (threadIdx.x == 0) {
        unsigned* bar = b.bar;
        __builtin_amdgcn_s_waitcnt(0);
        unsigned nloc = b.st[0], nx = b.st[1];
        if (nloc == 0u) { xcd_barrier_complete(bar, b.x, nloc, nx); b.st[0] = nloc; b.st[1] = nx; }
        const unsigned old = xb_add(&bar[XB_XSUB(b.x)], 1u);
        const unsigned gen = old / nloc;
        if (old + 1u == (gen + 1u) * nloc) {
            __builtin_amdgcn_fence(__ATOMIC_RELEASE, "agent");
            asm volatile("s_waitcnt vmcnt(0)" ::: "memory");
            const unsigned og = xb_add(&bar[XB_TOP], 1u);
            const unsigned tg = og / nx;
            if (og + 1u == (tg + 1u) * nx) xb_add(&bar[XB_TOPGEN], 1u);
            else XB_SPIN(xb_ld(&bar[XB_TOPGEN]) == tg, bar);
            __builtin_amdgcn_fence(__ATOMIC_ACQUIRE, "agent");
            xb_add(&bar[XB_XGEN(b.x)], 1u);
            asm volatile("s_waitcnt vmcnt(0)" ::: "memory");
        } else {
            XB_SPIN(xb_ld(&bar[XB_XGEN(b.x)]) == gen, bar);
            __builtin_amdgcn_fence(__ATOMIC_ACQUIRE, "agent");
            asm volatile("s_waitcnt vmcnt(0)" ::: "memory");
        }
    }
    __syncthreads();
}


constexpr int NSTEP = 22;
__global__ void __launch_bounds__(512, 2) fwd_kernel(Params Parg) {
  extern __shared__ __attribute__((aligned(16))) unsigned char shm[];
  LAS unsigned char* lds = (LAS unsigned char*)shm;
  KParams Pk = (KParams)__builtin_amdgcn_kernarg_segment_ptr();
  const int step_lo = Pk->step_lo, step_hi = Pk->step_hi;
  volatile LAS unsigned* xst = (volatile LAS unsigned*)(lds + LDS_BYTES);
  if (threadIdx.x == 0) { xst[0] = 0u; xst[1] = 0u; }
  __syncthreads();
  const XcdBarrier xb = xcd_barrier_post(Pk->bar, xst);
#ifndef REPEAT_MASK
#define REPEAT_MASK 0
#endif
#ifndef EXTRA_SYNCS
#define EXTRA_SYNCS 0
#endif
  for (int st2 = 2 * step_lo; st2 < 2 * step_hi; ++st2) {
    const int st = st2 >> 1;
    if ((st2 & 1) && !((REPEAT_MASK >> st) & 1)) continue;
    if (EXTRA_SYNCS && st2 == 2 * step_lo) { for (int i = 0; i < EXTRA_SYNCS; ++i) cg::this_grid().sync(); }
    KParams Pl = Pk; asm volatile("" : "+s"(Pl));
    bool sync_after = true;
    const int gi = Pl->step_gd[st];
    if (gi == -2) continue;
    if (gi >= 0) {
      if (EN(100 + 1) || EN(100 + 2) || EN(100 + 3)) {
      const __attribute__((address_space(4))) GD& d = Pl->gd[gi];
      Gemm g{d.A, d.Bt, d.M, d.N, d.K, d.lda, d.ldb, d.gate};
      StaticOrder S; S.init(g.M, g.N, (int)gridDim.x, (int)blockIdx.x);
      if (d.kind == 1) { if (EN(101)) { EpiBf e{(bf16_t*)d.p0, d.ld0, (bf16_t*)d.p1, d.ld1, d.split, d.mode, (const float*)d.q0, (const u64_t*)d.q1, __int_as_float(d.pad), (u64_t*)d.q2, (u64_t*)d.q3}; pg8::gemm_phase<EpiBf>(lds, g, S, e); } }
      else if (d.kind == 2) { if (EN(102)) { EpiRes e{(const float*)d.q0, (const bf16_t*)d.q2, (float*)d.p0, (bf16_t*)d.p1, (u64_t*)d.q1}; pg8::gemm_phase<EpiRes>(lds, g, S, e); } }
      else { if (EN(103)) { EpiGate e{(const bf16_t*)d.q0, (const float*)d.q1, (const float*)d.q2, (const float*)d.q3, (bf16_t*)d.p0, (bf16_t*)d.p1}; pg8::gemm_phase<EpiGate>(lds, g, S, e); } }
      }
      if (st == 1 && gridDim.x == 256 && blockIdx.x >= 128)
        convert_tiles(Pl, lds, CVT_TOTAL - CVT_DEFER + ((int)blockIdx.x - 128), 128, CVT_TOTAL);
      if (st == 3) sync_after = false;
    } else {
      KParams P = Pl;
      bf16_t* const X = P->X;
      bf16_t* const lat = X + (size_t)T_TOK * 3072;
      bf16_t* const ybuf = X; bf16_t* const xr = X + (size_t)T_TOK * DM; bf16_t* const labuf = xr + (size_t)T_TOK * DM; bf16_t* const bbuf = (bf16_t*)P->out;
      float* const asum = (float*)xr; float* const hend = asum + (size_t)NB * 128 * DM;
      const int layer = (st >= 10) ? 1 : 0;
      switch (st) {
        case 0: if (EN(0)) { phase_convert(P, lds); phase_rmsnorm(P->x, P->norm_mix, P->act, nullptr); } break;
        case 2: if (EN(2)) phase_prep(P, lat); break;
        case 5: if (EN(5)) phase_attention(P, lds); break;
        case 7: case 18: if (EN(7)) phase_rmsnorm(P->out, P->norm_mlp + layer * DM, P->act, nullptr); break;
        case 10: if (EN(7)) phase_rmsnorm(P->out, P->norm_mix + DM, P->act, nullptr); break;
        case 12: if (EN(12)) phase_conv(P, xr, P->act); break;
        case 14: if (EN(14)) phase_scan1(labuf, bbuf, asum, hend); break;
        case 15: if (EN(15)) phase_scan_carry(asum, hend); break;
        case 16: if (EN(16)) phase_scan2(labuf, bbuf, ybuf, hend, P->act); break;
        case 21: if (EN(7)) phase_rmsnorm(P->out, P->norm_final, nullptr, P->out); break;
        default: break;
      }
    }
    { const bool last_exec = (st + 1 >= step_hi) && ((st2 & 1) || !((REPEAT_MASK >> st) & 1));
      if (sync_after && !last_exec) { if (step_lo > 1000) cg::this_grid().sync(); else xcd_barrier(xb); } }
  }
}

extern "C" void kernel_launch(void* const* d_in, const int* in_sizes, int n_in, void* d_out, int out_size, void* d_ws, size_t ws_size, hipStream_t stream) {
  static int grid_blocks = 0;
  if (!grid_blocks) {
    hipFuncSetAttribute((const void*)fwd_kernel, hipFuncAttributeMaxDynamicSharedMemorySize, LDS_BYTES + 16);
    int dev = 0, cus = 0, per_cu = 0;
    hipGetDevice(&dev);
    hipDeviceGetAttribute(&cus, hipDeviceAttributeMultiprocessorCount, dev);
    hipOccupancyMaxActiveBlocksPerMultiprocessor(&per_cu, fwd_kernel, 512, LDS_BYTES);
    if (per_cu < 1) per_cu = 1;
    grid_blocks = cus;
  }
  Params p;
  memset(&p, 0, sizeof(p));
  p.x = (const float*)d_in[0]; p.pos = (const int*)d_in[1]; p.norm_mix = (const float*)d_in[2]; p.norm_mlp = (const float*)d_in[3]; p.norm_final = (const float*)d_in[4];
  p.w_in = (const float*)d_in[5]; p.lq1 = (const float*)d_in[6]; p.lk1 = (const float*)d_in[7]; p.lq2 = (const float*)d_in[8]; p.lk2 = (const float*)d_in[9]; p.subln = (const float*)d_in[10];
  p.q_norm = (const float*)d_in[11]; p.kv_norm = (const float*)d_in[12]; p.w_uq = (const float*)d_in[13]; p.w_ukv = (const float*)d_in[14]; p.w_out = (const float*)d_in[15];
  p.rw_in = (const float*)d_in[16]; p.conv_w = (const float*)d_in[17]; p.conv_b = (const float*)d_in[18]; p.w_a = (const float*)d_in[19]; p.b_a = (const float*)d_in[20]; p.w_x = (const float*)d_in[21]; p.b_x = (const float*)d_in[22];
  p.rlam = (const float*)d_in[23]; p.rw_out = (const float*)d_in[24]; p.w1 = (const float*)d_in[25]; p.w2 = (const float*)d_in[26];
  p.out = (float*)d_out;
  bf16_t* w = (bf16_t*)d_ws;
  p.Wt_in = w;  w += (size_t)4416 * 2048;
  p.Wt_uq = w;  w += (size_t)1536 * 768;
  p.Wt_ukv = w; w += (size_t)2048 * 512;
  p.Wt_out = w; w += (size_t)2048 * 2048;
  p.Wt_rin = w; w += (size_t)4096 * 2048;
  p.Wt_gate = w; w += (size_t)4096 * 256;
  p.Wt_rout = w; w += (size_t)2048 * 2048;
  p.Wt_w1 = w;  w += (size_t)2 * 8192 * 2048;
  p.Wt_w2 = w;  w += (size_t)2 * 8192 * 2048;
  p.act = w;    w += (size_t)T_TOK * DM;
  p.X = w;      w += (size_t)T_TOK * 8192;
  p.cs = (float*)w; w += (size_t)T_TOK * 32 * 2 * 2;
  p.sp8 = (float*)w; w += (size_t)DM * 2;
  p.bar = (unsigned*)w; w += (size_t)XCD_BAR_WORDS * 2;
  p.ssq = (u64_t*)w; w += (size_t)5 * T_TOK * 4;
  for (int i = 0; i < 32; ++i) p.inv_freq[i] = 1.0f / powf(10000.0f, (float)(2 * i) / 64.0f);
  {
    bf16_t* const X = p.X;
    bf16_t* const qkva = X; bf16_t* const lat = X + (size_t)T_TOK * 3072; bf16_t* const qbuf = lat + (size_t)T_TOK * 1536; bf16_t* const kvbuf = qbuf + (size_t)T_TOK * 1536;
    bf16_t* const ybuf = X; bf16_t* const xr = X + (size_t)T_TOK * DM; bf16_t* const labuf = xr + (size_t)T_TOK * DM; bf16_t* const bbuf = labuf + (size_t)T_TOK * DM;
    for (int i = 0; i < 24; ++i) p.step_gd[i] = -1;
    int n = 0;
    auto add = [&](int step, const bf16_t* A, const bf16_t* Bt, int M, int N, int K, int lda, int ldb, int gate, int kind, void* p0, void* p1, const void* q0, const void* q1, const void* q2, const void* q3, int ld0, int ld1, int split, int mode, float inv_n) {
      GD& d = p.gd[n]; d.A = A; d.Bt = Bt; d.p0 = p0; d.p1 = p1; d.q0 = q0; d.q1 = q1; d.q2 = q2; d.q3 = q3; d.M = M; d.N = N; d.K = K; d.lda = lda; d.ldb = ldb; d.gate = gate; d.kind = kind; d.ld0 = ld0; d.ld1 = ld1; d.split = split; d.mode = mode;
      { const float sc = inv_n / 1048576.f; memcpy(&d.pad, &sc, 4); }
      p.step_gd[step] = n++; };
    bf16_t* const HB = X + (size_t)T_TOK * 6144;
    bf16_t* const U = p.act;
    u64_t* const sq0 = p.ssq; u64_t* const sq1 = p.ssq + T_TOK; u64_t* const sq2 = p.ssq + 2 * T_TOK; u64_t* const sqq = p.ssq + 3 * T_TOK; u64_t* const sqkv = p.ssq + 4 * T_TOK;
    add(1, p.act, p.Wt_in, T_TOK, 4608, 2048, 2048, 2048, 0, 1, qkva, lat, p.cs, nullptr, sqq, sqkv, 3072, 1536, 12, 4, 0.f);
    p.step_gd[2] = -2;
    add(3, lat, p.Wt_uq, T_TOK, 1536, 768, 1536, 768, 0, 1, qbuf, qbuf, p.cs, sqq, nullptr, nullptr, 1536, 1536, 1000, 3, 1.f / 768.f);
    add(4, lat + 768, p.Wt_ukv, T_TOK, 2048, 512, 1536, 512, 0, 1, kvbuf, kvbuf, nullptr, sqkv, nullptr, nullptr, 2048, 2048, 1000, 0, 1.f / 512.f);
    add(6, p.act, p.Wt_out, T_TOK, 2048, 2048, 2048, 2048, 0, 2, nullptr, HB, p.x, sq0, nullptr, nullptr, 0, 0, 0, 0, 0.f);
    p.step_gd[7] = -2;
    add(8, HB, p.Wt_w1, T_TOK, 8192, 2048, 2048, 2048, 0, 1, U, U, nullptr, sq0, nullptr, nullptr, 8192, 8192, 1000, 1, 1.f / 2048.f);
    add(9, U, p.Wt_w2, T_TOK, 2048, 8192, 8192, 8192, 0, 2, nullptr, HB, nullptr, sq1, HB, nullptr, 0, 0, 0, 0, 0.f);
    p.step_gd[10] = -2;
    add(11, HB, p.Wt_rin, T_TOK, 4096, 2048, 2048, 2048, 0, 1, ybuf, xr, nullptr, sq1, nullptr, nullptr, 2048, 2048, 8, 2, 1.f / 2048.f);
    add(13, p.act, p.Wt_gate, T_TOK, 4096, 256, 2048, 256, 1, 3, labuf, (bf16_t*)p.out, p.act, p.b_a, p.b_x, p.sp8, 0, 0, 0, 0, 0.f);
    add(17, p.act, p.Wt_rout, T_TOK, 2048, 2048, 2048, 2048, 0, 2, nullptr, HB, nullptr, sq2, HB, nullptr, 0, 0, 0, 0, 0.f);
    p.step_gd[18] = -2;
    add(19, HB, p.Wt_w1 + (size_t)8192 * 2048, T_TOK, 8192, 2048, 2048, 2048, 0, 1, U, U, nullptr, sq2, nullptr, nullptr, 8192, 8192, 1000, 1, 1.f / 2048.f);
    add(20, U, p.Wt_w2 + (size_t)8192 * 2048, T_TOK, 2048, 8192, 8192, 8192, 0, 2, p.out, nullptr, nullptr, nullptr, HB, nullptr, 0, 0, 0, 0, 0.f);
  }
#if N_LAUNCH_MODE == 1
  p.step_lo = 0; p.step_hi = NSTEP;
  hipMemsetAsync(p.bar, 0, XCD_BAR_WORDS * 4, stream);
  void* args[] = {&p};
  hipError_t e = hipLaunchCooperativeKernel((const void*)fwd_kernel, dim3(grid_blocks), dim3(512), args, LDS_BYTES + 16, stream);
  if (e != hipSuccess) fprintf(stderr, "cooperative launch failed: %s (grid %d)\n", hipGetErrorString(e), grid_blocks);
#else
  for (int st = 0; st < NSTEP; ++st) {
    p.step_lo = st; p.step_hi = st + 1;
    hipLaunchKernelGGL(fwd_kernel, dim3(grid_blocks), dim3(512), LDS_BYTES + 16, stream, p);
  }
#endif
}
#ifdef TESTK
__global__ void __launch_bounds__(512, 2) tk1(Gemm g, EpiBf e) { extern __shared__ __attribute__((aligned(16))) unsigned char shm[]; StaticOrder S; S.init(g.M, g.N, (int)gridDim.x, (int)blockIdx.x); pg8::gemm_phase<EpiBf>((LAS unsigned char*)shm, g, S, e); }
__global__ void __launch_bounds__(512, 2) tk2(Gemm g, EpiRes e) { extern __shared__ __attribute__((aligned(16))) unsigned char shm[]; StaticOrder S; S.init(g.M, g.N, (int)gridDim.x, (int)blockIdx.x); pg8::gemm_phase<EpiRes>((LAS unsigned char*)shm, g, S, e); }
__global__ void __launch_bounds__(512, 2) tk3(Gemm g, EpiGate e) { extern __shared__ __attribute__((aligned(16))) unsigned char shm[]; StaticOrder S; S.init(g.M, g.N, (int)gridDim.x, (int)blockIdx.x); pg8::gemm_phase<EpiGate>((LAS unsigned char*)shm, g, S, e); }
#endif
```
